# Optimizing an MI355X kernel written in HIP

```python
import functools
import jax, jax.numpy as jnp
from jax import lax
import numpy as np

D_MODEL = 1024
BATCH = 2
SEQ = 8192
DEPTH = 1
DEC_BATCH = 128
DEC_SEQ = 8
PAST_LEN = 16384
PAGE_SIZE = 128

HEAD_DIM = 64
ROT_DIM = HEAD_DIM // 4
ROPE_THETA = 500000.0
ATTN_SCALE = HEAD_DIM ** -0.5
BLOCK = 128
N_HEADS_A = 8
N_KV_A = 2
GROUP_A = N_HEADS_A // N_KV_A
WINDOW_A = 128
DIL_GROUPS = ((128, 1), (512, 4), (2048, 16))
N_DIL = 3
N_KV_B = 4
N_HEADS_B = N_DIL * N_KV_B
WINDOW_B = 2048
Q_A_W = N_HEADS_A * HEAD_DIM
KV_A_W = N_KV_A * HEAD_DIM
Q_B_W = N_HEADS_B * HEAD_DIM
KV_B_W = N_KV_B * HEAD_DIM
IN_COLS = Q_A_W + 2 * KV_A_W + Q_B_W + 2 * KV_B_W + 2 * D_MODEL
N_MEM = 256
MEM_HEADS = 4
MEM_HEAD_DIM = 128
MEM_WIDTH = MEM_HEADS * MEM_HEAD_DIM
MEM_SCALE = MEM_HEAD_DIM ** -0.5
D_FF = 2816
RMS_EPS = 1e-6

kernel_name = 'hybrid_swa_dilated_memory_decoder_step'


def rmsnorm(x, g):
    xf = x.astype(jnp.float32)
    xf = xf * lax.rsqrt(jnp.mean(xf * xf, axis=-1, keepdims=True) + RMS_EPS)
    return (xf * g.astype(jnp.float32)).astype(x.dtype)


def swiglu_half(x, norm_g, w_gate, w_up, w_down):
    u = rmsnorm(x, norm_g)
    return x + 0.5 * ((jax.nn.silu(u @ w_gate) * (u @ w_up)) @ w_down)


def rope(x, pos):
    half = ROT_DIM // 2
    inv_freq = jnp.power(jnp.float32(ROPE_THETA), -jnp.arange(half, dtype=jnp.float32) / half)
    ang = pos.astype(jnp.float32)[:, None] * inv_freq[None, :]
    cos = jnp.cos(ang)[:, None, :].astype(x.dtype)
    sin = jnp.sin(ang)[:, None, :].astype(x.dtype)
    x1, x2, rest = x[..., :half], x[..., half:ROT_DIM], x[..., ROT_DIM:]
    return jnp.concatenate([x1 * cos - x2 * sin, x2 * cos + x1 * sin, rest], axis=-1)


def band_attn(q, k, v, steps):
    n, s, kv, g, dh = q.shape
    pad = (-s) % BLOCK
    if pad:
        q = jnp.pad(q, ((0, 0), (0, pad), (0, 0), (0, 0), (0, 0)))
        k = jnp.pad(k, ((0, 0), (0, pad), (0, 0), (0, 0)))
        v = jnp.pad(v, ((0, 0), (0, pad), (0, 0), (0, 0)))
    nb = (s + pad) // BLOCK
    qb = q.reshape(n, nb, BLOCK, kv, g, dh)

    def with_prev(x):
        xb = x.reshape(n, nb, BLOCK, kv, dh)
        prev = jnp.concatenate([jnp.zeros_like(xb[:, :1]), xb[:, :-1]], axis=1)
        return jnp.concatenate([prev, xb], axis=2)

    kk, vv = with_prev(k), with_prev(v)
    sc = jnp.einsum('nbqkgd,nbjkd->nbkgqj', qb, kk, preferred_element_type=jnp.float32) * ATTN_SCALE
    qi = jnp.arange(BLOCK)[:, None]
    kj = jnp.arange(2 * BLOCK)[None, :]
    dist = qi + BLOCK - kj
    band = (dist >= 0) & (dist <= steps)
    has_prev = (jnp.arange(nb) > 0)[:, None, None] | (kj >= BLOCK)[None]
    mask = band[None] & has_prev
    sc = jnp.where(mask[None, :, None, None], sc, -jnp.inf)
    lse = jax.nn.logsumexp(sc, axis=-1)
    p = jnp.exp(sc - lse[..., None]).astype(v.dtype)
    o = jnp.einsum('nbkgqj,nbjkd->nbqkgd', p, vv, preferred_element_type=jnp.float32)
    o = o.reshape(n, nb * BLOCK, kv, g, dh)[:, :s]
    lse = jnp.transpose(lse, (0, 1, 4, 2, 3)).reshape(n, nb * BLOCK, kv, g)[:, :s]
    return o, lse


def dilated_band_attn(q, k, v, dilation, steps):
    n, s = q.shape[:2]
    sd = s // dilation

    def split(x):
        rest = x.shape[2:]
        x = jnp.moveaxis(x.reshape(n, sd, dilation, *rest), 2, 1)
        return x.reshape(n * dilation, sd, *rest)

    def merge(x):
        rest = x.shape[2:]
        x = jnp.moveaxis(x.reshape(n, dilation, sd, *rest), 1, 2)
        return x.reshape(n, s, *rest)

    o, lse = band_attn(split(q), split(k), split(v), steps)
    return merge(o), merge(lse)


def gather_attn(q, k_all, v_all, dilation, steps):
    t = q.shape[1]
    n_past = k_all.shape[1] - t
    idx = (n_past + jnp.arange(t))[:, None] - dilation * jnp.arange(steps + 1)[None, :]
    valid = idx >= 0
    idx = jnp.maximum(idx, 0)
    kg = jnp.take(k_all, idx, axis=1)
    vg = jnp.take(v_all, idx, axis=1)
    sc = jnp.einsum('ntkgd,ntjkd->ntkgj', q, kg, preferred_element_type=jnp.float32) * ATTN_SCALE
    sc = jnp.where(valid[None, :, None, None, :], sc, -jnp.inf)
    lse = jax.nn.logsumexp(sc, axis=-1)
    p = jnp.exp(sc - lse[..., None]).astype(v_all.dtype)
    o = jnp.einsum('ntkgj,ntjkd->ntkgd', p, vg, preferred_element_type=jnp.float32)
    return o, lse


def cached_attn(q, k, v, dilation, steps, k_past, v_past):
    return gather_attn(q, jnp.concatenate([k_past, k], axis=1), jnp.concatenate([v_past, v], axis=1), dilation, steps)


def project_mixers(h, pos, mix_norm, w_in):
    n, s, _ = h.shape
    z = rmsnorm(h, mix_norm) @ w_in
    sizes = (Q_A_W, KV_A_W, KV_A_W, Q_B_W, KV_B_W, KV_B_W, D_MODEL, D_MODEL)
    q_a, k_a, v_a, q_b, k_b, v_b, g_a, g_b = jnp.split(z, np.cumsum(sizes)[:-1].tolist(), axis=-1)
    q_a = rope(q_a.reshape(n, s, N_HEADS_A, HEAD_DIM), pos).reshape(n, s, N_KV_A, GROUP_A, HEAD_DIM)
    k_a = rope(k_a.reshape(n, s, N_KV_A, HEAD_DIM), pos)
    v_a = v_a.reshape(n, s, N_KV_A, HEAD_DIM)
    q_b = rope(q_b.reshape(n, s, N_HEADS_B, HEAD_DIM), pos).reshape(n, s, N_DIL, N_KV_B, HEAD_DIM)
    k_b = rope(k_b.reshape(n, s, N_KV_B, HEAD_DIM), pos)
    v_b = v_b.reshape(n, s, N_KV_B, HEAD_DIM)
    return q_a, k_a, v_a, q_b, k_b, v_b, g_a, g_b


def memory_kv(mem, norm_g, w_k, w_v):
    n, m, _ = mem.shape
    u = rmsnorm(mem, norm_g)
    return ((u @ w_k).reshape(n, m, MEM_HEADS, MEM_HEAD_DIM), (u @ w_v).reshape(n, m, MEM_HEADS, MEM_HEAD_DIM))


def cross_attn(h, mem_k, mem_v, norm_g, w_q, w_o):
    n, s, _ = h.shape
    q = (rmsnorm(h, norm_g) @ w_q).reshape(n, s, MEM_HEADS, MEM_HEAD_DIM)
    sc = jnp.einsum('nshd,nmhd->nhsm', q, mem_k, preferred_element_type=jnp.float32) * MEM_SCALE
    p = jax.nn.softmax(sc, axis=-1).astype(mem_v.dtype)
    o = jnp.einsum('nhsm,nmhd->nshd', p, mem_v, preferred_element_type=jnp.float32)
    return o.astype(h.dtype).reshape(n, s, MEM_WIDTH) @ w_o


def decoder_layer(x, pos, attn_a, attn_b, mem_k, mem_v, ffn1, mix, cross, ffn2):
    n, s, _ = x.shape
    h = swiglu_half(x, *ffn1)
    mix_norm, w_in, sink, w_branch_a, w_branch_b, w_out = mix
    q_a, k_a, v_a, q_b, k_b, v_b, g_a, g_b = project_mixers(h, pos, mix_norm, w_in)
    o_a, lse_a = attn_a(q_a, k_a, v_a)
    o_a = o_a * jax.nn.sigmoid(lse_a - sink.astype(jnp.float32).reshape(N_KV_A, GROUP_A))[..., None]
    outs, lses = [], []
    for g, (window, dilation) in enumerate(DIL_GROUPS):
        o, lse = attn_b(q_b[:, :, g, :, None], k_b, v_b, dilation, window // dilation)
        outs.append(o)
        lses.append(lse)
    wts = jax.nn.softmax(jnp.stack(lses), axis=0)
    o_b = jnp.sum(wts[..., None] * jnp.stack(outs), axis=0)
    branch_a = o_a.astype(h.dtype).reshape(n, s, Q_A_W) @ w_branch_a
    branch_b = o_b.astype(h.dtype).reshape(n, s, KV_B_W) @ w_branch_b
    h = h + (jax.nn.sigmoid(g_a) * branch_a + jax.nn.sigmoid(g_b) * branch_b) @ w_out
    h = h + cross_attn(h, mem_k, mem_v, *cross)
    h = swiglu_half(h, *ffn2)
    return h, k_a, v_a, k_b, v_b


def setup_inputs(seed: int = 0) -> dict:
    key = jax.random.key(seed)
    keys = iter(jax.random.split(key, 40))

    def normal(shape, scale=1.0):
        return scale * jax.random.normal(next(keys), shape, jnp.float32)

    def gain(shape):
        return 1.0 + 0.1 * normal(shape)

    l_a = min(WINDOW_A, PAST_LEN)
    l_b = min(WINDOW_B, PAST_LEN)
    d = D_MODEL
    return {
        'x_prompt': normal((BATCH, SEQ, d)),
        'x_sample': normal((DEC_BATCH, DEC_SEQ, d)),
        'cache_swa_k': normal((DEPTH, DEC_BATCH, l_a, N_KV_A, HEAD_DIM)),
        'cache_swa_v': normal((DEPTH, DEC_BATCH, l_a, N_KV_A, HEAD_DIM)),
        'cache_dil_k': normal((DEPTH, DEC_BATCH, l_b, N_KV_B, HEAD_DIM)),
        'cache_dil_v': normal((DEPTH, DEC_BATCH, l_b, N_KV_B, HEAD_DIM)),
        'cache_mem_k': normal((DEPTH, DEC_BATCH, N_MEM, MEM_HEADS, MEM_HEAD_DIM)),
        'cache_mem_v': normal((DEPTH, DEC_BATCH, N_MEM, MEM_HEADS, MEM_HEAD_DIM)),
        'mem_prompt': normal((BATCH, N_MEM, d)),
        'ffn1_norm': gain((DEPTH, d)),
        'ffn1_w_gate': normal((DEPTH, d, D_FF), d ** -0.5),
        'ffn1_w_up': normal((DEPTH, d, D_FF), d ** -0.5),
        'ffn1_w_down': normal((DEPTH, D_FF, d), D_FF ** -0.5),
        'mix_norm': gain((DEPTH, d)),
        'w_in': normal((DEPTH, d, IN_COLS), d ** -0.5),
        'attn_sink': normal((DEPTH, N_HEADS_A)),
        'w_branch_a': normal((DEPTH, Q_A_W, d), Q_A_W ** -0.5),
        'w_branch_b': normal((DEPTH, KV_B_W, d), KV_B_W ** -0.5),
        'w_out': normal((DEPTH, d, d), d ** -0.5),
        'mem_q_norm': gain((DEPTH, d)),
        'mem_kv_norm': gain((DEPTH, d)),
        'w_mem_q': normal((DEPTH, d, MEM_WIDTH), d ** -0.5),
        'w_mem_k': normal((DEPTH, d, MEM_WIDTH), d ** -0.5),
        'w_mem_v': normal((DEPTH, d, MEM_WIDTH), d ** -0.5),
        'w_mem_o': normal((DEPTH, MEM_WIDTH, d), MEM_WIDTH ** -0.5),
        'ffn2_norm': gain((DEPTH, d)),
        'ffn2_w_gate': normal((DEPTH, d, D_FF), d ** -0.5),
        'ffn2_w_up': normal((DEPTH, d, D_FF), d ** -0.5),
        'ffn2_w_down': normal((DEPTH, D_FF, d), D_FF ** -0.5),
        'final_norm': gain((d,)),
    }


def reference(x_prompt, x_sample, cache_swa_k, cache_swa_v, cache_dil_k, cache_dil_v, cache_mem_k, cache_mem_v,
              mem_prompt, ffn1_norm, ffn1_w_gate, ffn1_w_up, ffn1_w_down, mix_norm, w_in, attn_sink, w_branch_a,
              w_branch_b, w_out, mem_q_norm, mem_kv_norm, w_mem_q, w_mem_k, w_mem_v, w_mem_o, ffn2_norm,
              ffn2_w_gate, ffn2_w_up, ffn2_w_down, final_norm):
    s = x_prompt.shape[1]
    t = x_sample.shape[1]
    pos_p = jnp.arange(s, dtype=jnp.int32)
    pos_s = PAST_LEN + jnp.arange(t, dtype=jnp.int32)
    keep_a = min(WINDOW_A, s)
    keep_b = min(WINDOW_B, s)
    prompt_attn_a = functools.partial(dilated_band_attn, dilation=1, steps=WINDOW_A)
    hp, hs = x_prompt, x_sample
    rows = []
    for l in range(DEPTH):
        ffn1 = (ffn1_norm[l], ffn1_w_gate[l], ffn1_w_up[l], ffn1_w_down[l])
        mix = (mix_norm[l], w_in[l], attn_sink[l], w_branch_a[l], w_branch_b[l], w_out[l])
        cross = (mem_q_norm[l], w_mem_q[l], w_mem_o[l])
        ffn2 = (ffn2_norm[l], ffn2_w_gate[l], ffn2_w_up[l], ffn2_w_down[l])
        mk_p, mv_p = memory_kv(mem_prompt, mem_kv_norm[l], w_mem_k[l], w_mem_v[l])
        hp, ka_p, va_p, kb_p, vb_p = decoder_layer(hp, pos_p, prompt_attn_a, dilated_band_attn,
                                                   mk_p, mv_p, ffn1, mix, cross, ffn2)
        sample_attn_a = functools.partial(cached_attn, dilation=1, steps=WINDOW_A,
                                          k_past=cache_swa_k[l], v_past=cache_swa_v[l])
        sample_attn_b = functools.partial(cached_attn, k_past=cache_dil_k[l], v_past=cache_dil_v[l])
        hs, ka_s, va_s, kb_s, vb_s = decoder_layer(hs, pos_s, sample_attn_a, sample_attn_b,
                                                   cache_mem_k[l], cache_mem_v[l], ffn1, mix, cross, ffn2)
        rows.append((ka_p[:, s - keep_a:], va_p[:, s - keep_a:], kb_p[:, s - keep_b:], vb_p[:, s - keep_b:],
                     mk_p, mv_p, ka_s, va_s, kb_s, vb_s))
    (swa_k_p, swa_v_p, dil_k_p, dil_v_p, mem_k_p, mem_v_p,
     swa_k_s, swa_v_s, dil_k_s, dil_v_s) = [jnp.stack(c) for c in zip(*rows)]
    y_prompt = rmsnorm(hp, final_norm)
    y_sample = rmsnorm(hs, final_norm)
    return (y_prompt, y_sample, swa_k_p, swa_v_p, dil_k_p, dil_v_p, mem_k_p, mem_v_p,
            swa_k_s, swa_v_s, dil_k_s, dil_v_s)
```

```cpp
#include <hip/hip_runtime.h>
#include <hip/hip_cooperative_groups.h>
#include <cstdio>
#include <cstdint>
namespace cg = cooperative_groups;
__device__ __forceinline__ int lane_id() { int l; asm volatile("v_mbcnt_lo_u32_b32 %0, -1, 0\n\tv_mbcnt_hi_u32_b32 %0, -1, %0" : "=v"(l)); return l; }
namespace pg8 {
#define PG8_LAS __attribute__((address_space(3)))
typedef unsigned short bf16_t;
typedef short bf16x8 __attribute__((ext_vector_type(8)));
typedef float f32x4 __attribute__((ext_vector_type(4)));
typedef unsigned u32x4 __attribute__((ext_vector_type(4)));
constexpr int BM = 256, BK = 64, HALF = 128, HTB = HALF * BK * 2  , STAGE_BYTES = 8 * HTB, NXCD = 8, WGM = 8;

__host__ __device__ __forceinline__ int lds_byte(int r, int c) { const int st = (r >> 4) * 2 + (c >> 5), rr = r & 15, cc = c & 31, ob = rr * 64 + cc * 2; return st * 1024 + (ob ^ (((ob >> 9) & 1) << 5)); }
__host__ __device__ __forceinline__ void stage_rc(int b, int& R, int& C) { const int st = b / 1024, sb = b % 1024, swz = sb ^ (((sb >> 9) & 1) << 5); R = (st >> 1) * 16 + swz / 64; C = (st & 1) * 32 + (swz % 64) / 2; }
__host__ __device__ __forceinline__ int perm32(int rho) { const int n = rho >> 4, i = rho & 15; return 8 * (i >> 2) + 4 * n + (i & 3); }

struct Unit { int pm, pn; };
struct Gemm { const bf16_t* A; const bf16_t* Bt; int M, N, K; };

struct StaticOrder {
    int nM, nN, nwg, G, c;
    __host__ __device__ void init(int M, int N, int G_, int c_) { nM = M / BM; nN = N / BM; nwg = nM * nN; G = G_; c = c_; }
    __host__ __device__ bool next(int i, Unit& u) const {
        const long L = (long)i * G + c; if (L >= nwg) return false;
        int wgid = (int)L; { const int q = nwg / NXCD, r = nwg % NXCD, xcd = wgid % NXCD, off = wgid / NXCD; wgid = (xcd < r ? xcd * (q + 1) : r * (q + 1) + (xcd - r) * q) + off; }
        const int nig = WGM * nN, gid = wgid / nig, fm = gid * WGM, gsz = (nM - fm) < WGM ? (nM - fm) : WGM;
        u.pm = fm + ((wgid % nig) % gsz); u.pn = (wgid % nig) / gsz; return true;
    }
    __device__ __forceinline__ void a_ready(const Unit&) const {}
    __device__ __forceinline__ void done(const Unit&) const {}
};
typedef __bf16 bf16x2_t __attribute__((ext_vector_type(2)));
typedef float f32x2_t __attribute__((ext_vector_type(2)));
__device__ __forceinline__ unsigned cvt_pk_bf16(float lo, float hi) { const f32x2_t v = {lo, hi}; const bf16x2_t r = __builtin_convertvector(v, bf16x2_t); return __builtin_bit_cast(unsigned, r); }
template <class Epi, class Sched, bool ALIGN_EPI = false, bool SP2 = false>
__device__ __forceinline__ void gemm_phase(PG8_LAS unsigned char* lds, const Gemm g, const Sched& S, const Epi& E, const int wid, PG8_LAS float* rsbuf) {
    const int lane = lane_id(), tid = wid * 64 + lane, wr = wid >> 2, wc = wid & 3, fr = lane & 15, fq = lane >> 4;
    const int K = g.K, nt = K / BK;
    unsigned voffA[2], voffB[2];
#pragma unroll
    for (int i = 0; i < 2; ++i) { int R, C; stage_rc(tid * 16 + i * 8192, R, C); const int Rb = Epi::PERM ? ((R & ~31) + perm32(R & 31)) : R;
        voffA[i] = (unsigned)(R * K + C) * 2u; voffB[i] = (unsigned)(Rb * K + C) * 2u; }
    const size_t kstep = (size_t)(BK * 2);
    const size_t hstep = (size_t)HALF * K * 2;
    const size_t tstep = 2 * hstep;
    const unsigned ldsw = (unsigned)wid * 1024u;
    const int aoff = lds_byte(wr * 64 + fr, fq * 8), boff = lds_byte(wc * 32 + fr, fq * 8);
#define PG8_SA(b, h) (((b) * 2 + (h)) * HTB)
#define PG8_SB(b, h) ((4 + (b) * 2 + (h)) * HTB)
#define PG8_STAGE(bufoff, gbase, voff) do { _Pragma("unroll") for (int _i = 0; _i < 2; ++_i) \
        __builtin_amdgcn_global_load_lds((const unsigned*)((const char*)(gbase) + (voff)[_i]), (PG8_LAS unsigned*)(lds + (bufoff) + ldsw + _i * 8192), 16, 0, 0); } while (0)
#define PG8_LDA(dst, b, h) do { _Pragma("unroll") for (int m = 0; m < 4; ++m) _Pragma("unroll") for (int k = 0; k < 2; ++k) dst[m][k] = *(const PG8_LAS bf16x8*)(lds + PG8_SA(b, h) + aoff + m * 2048 + k * 1024); } while (0)
#define PG8_LDB(dst, b, h) do { _Pragma("unroll") for (int n = 0; n < 2; ++n) _Pragma("unroll") for (int k = 0; k < 2; ++k) dst[n][k] = *(const PG8_LAS bf16x8*)(lds + PG8_SB(b, h) + boff + n * 2048 + k * 1024); } while (0)
#define PG8_MMA(ai, bj, At, Bt) do { __builtin_amdgcn_s_setprio(1); _Pragma("unroll") for (int m = 0; m < 4; ++m) _Pragma("unroll") for (int n = 0; n < 2; ++n) _Pragma("unroll") for (int k = 0; k < 2; ++k) \
        acc[ai][bj][m][n] = __builtin_amdgcn_mfma_f32_16x16x32_bf16(Bt[n][k], At[m][k], acc[ai][bj][m][n], 0, 0, 0); __builtin_amdgcn_s_setprio(0); } while (0)
#define PG8_WAIT_V(n) asm volatile("s_waitcnt vmcnt(" #n ")" ::: "memory")
#define PG8_WAIT_L(n) asm volatile("s_waitcnt lgkmcnt(" #n ")" ::: "memory")
#define PG8_BAR __builtin_amdgcn_s_barrier()
#define PG8_SCHED __builtin_amdgcn_sched_barrier(0)
    Unit cur, nxt; int ui = 0;
    if (!S.next(0, cur)) return;
    if constexpr (Epi::USE_RS) E.rs_stage(cur, tid, rsbuf);
    f32x4 acc[2][2][4][2];
#pragma unroll
    for (int a = 0; a < 2; ++a)
#pragma unroll
        for (int b = 0; b < 2; ++b)
#pragma unroll
            for (int m = 0; m < 4; ++m)
#pragma unroll
                for (int n = 0; n < 2; ++n) acc[a][b][m][n] = (f32x4){0.f, 0.f, 0.f, 0.f};
    bf16x8 At[4][2], B0[2][2], B1[2][2];
    const char* cA = (const char*)g.A + (size_t)cur.pm * tstep; const char* cB = (const char*)g.Bt + (size_t)cur.pn * tstep;
    S.a_ready(cur);
    if constexpr (SP2) {
        PG8_STAGE(PG8_SB(0, 0), cB, voffB); PG8_STAGE(PG8_SB(0, 1), cB + hstep, voffB); PG8_STAGE(PG8_SA(0, 0), cA, voffA); PG8_STAGE(PG8_SA(0, 1), cA + hstep, voffA);
        if (wr == 1) PG8_BAR;
        PG8_WAIT_V(2); PG8_BAR;
        PG8_STAGE(PG8_SB(1, 0), cB + kstep, voffB); PG8_STAGE(PG8_SA(1, 0), cA + kstep, voffA); PG8_STAGE(PG8_SB(1, 1), cB + hstep + kstep, voffB);
        PG8_WAIT_V(6); PG8_BAR;
    } else {
        PG8_STAGE(PG8_SB(0, 0), cB, voffB); PG8_STAGE(PG8_SA(0, 0), cA, voffA); PG8_STAGE(PG8_SB(0, 1), cB + hstep, voffB); PG8_STAGE(PG8_SA(0, 1), cA + hstep, voffA);
        if (wr == 1) PG8_BAR;
        PG8_WAIT_V(4); PG8_BAR;
        PG8_STAGE(PG8_SB(1, 0), cB + kstep, voffB); PG8_STAGE(PG8_SA(1, 0), cA + kstep, voffA); PG8_STAGE(PG8_SB(1, 1), cB + hstep + kstep, voffB);
        PG8_WAIT_V(6); PG8_BAR;
    }
    for (;;) {
        const bool has_next = S.next(ui + 1, nxt);
        const char* nA = has_next ? (const char*)g.A + (size_t)nxt.pm * tstep : cA; const char* nB = has_next ? (const char*)g.Bt + (size_t)nxt.pn * tstep : cB;
        for (int t = 0; t < nt; t += 2) {
            const bool last = (t == nt - 2);
            const char* a1 = cA + (size_t)(t + 1) * kstep;
            const char* a2 = last ? nA : cA + (size_t)(t + 2) * kstep; const char* b2 = last ? nB : cB + (size_t)(t + 2) * kstep;
            const char* a3 = a2 + kstep; const char* b3 = b2 + kstep;
            if (last && has_next) S.a_ready(nxt);
            if constexpr (SP2) {
            PG8_LDB(B0, 0, 0); PG8_LDB(B1, 0, 1); PG8_SCHED; PG8_LDA(At, 0, 0); PG8_STAGE(PG8_SA(1, 1), a1 + hstep, voffA);
            PG8_WAIT_V(8); PG8_WAIT_L(0); PG8_BAR; PG8_MMA(0, 0, At, B0); PG8_MMA(0, 1, At, B1); PG8_BAR; PG8_SCHED;
            PG8_LDA(At, 0, 1); PG8_STAGE(PG8_SB(0, 0), b2, voffB); PG8_STAGE(PG8_SB(0, 1), b2 + hstep, voffB); PG8_STAGE(PG8_SA(0, 0), a2, voffA);
            PG8_WAIT_V(8); PG8_WAIT_L(0); PG8_BAR; PG8_MMA(1, 0, At, B0); PG8_MMA(1, 1, At, B1); PG8_BAR; PG8_SCHED;
            PG8_LDB(B0, 1, 0); PG8_LDB(B1, 1, 1); PG8_SCHED; PG8_LDA(At, 1, 0); PG8_STAGE(PG8_SA(0, 1), a2 + hstep, voffA);
            PG8_WAIT_V(8); PG8_WAIT_L(0); PG8_BAR; PG8_MMA(0, 0, At, B0); PG8_MMA(0, 1, At, B1); PG8_BAR; PG8_SCHED;
            PG8_LDA(At, 1, 1); PG8_STAGE(PG8_SB(1, 0), b3, voffB); PG8_STAGE(PG8_SB(1, 1), b3 + hstep, voffB); PG8_STAGE(PG8_SA(1, 0), a3, voffA);
            PG8_WAIT_V(8); PG8_WAIT_L(0); PG8_BAR; PG8_MMA(1, 0, At, B0); PG8_MMA(1, 1, At, B1); PG8_BAR; PG8_SCHED;
            } else {
            PG8_LDB(B0, 0, 0); PG8_SCHED; PG8_LDA(At, 0, 0); PG8_STAGE(PG8_SA(1, 1), a1 + hstep, voffA);
            PG8_WAIT_L(8); PG8_BAR; PG8_WAIT_L(0); PG8_MMA(0, 0, At, B0); PG8_BAR; PG8_SCHED;
            PG8_LDB(B1, 0, 1); PG8_STAGE(PG8_SB(0, 0), b2, voffB);
            PG8_BAR; PG8_WAIT_L(0); PG8_MMA(0, 1, At, B1); PG8_BAR;
            PG8_LDA(At, 0, 1); PG8_STAGE(PG8_SA(0, 0), a2, voffA);
            PG8_BAR; PG8_WAIT_L(0); PG8_MMA(1, 0, At, B0); PG8_BAR; PG8_SCHED;
            PG8_STAGE(PG8_SB(0, 1), b2 + hstep, voffB);
            PG8_WAIT_V(6); PG8_BAR; PG8_MMA(1, 1, At, B1); PG8_BAR;
            PG8_LDB(B0, 1, 0); PG8_SCHED; PG8_LDA(At, 1, 0); PG8_STAGE(PG8_SA(0, 1), a2 + hstep, voffA);
            PG8_WAIT_L(8); PG8_BAR; PG8_WAIT_L(0); PG8_MMA(0, 0, At, B0); PG8_BAR; PG8_SCHED;
            PG8_LDB(B1, 1, 1); PG8_STAGE(PG8_SB(1, 0), b3, voffB);
            PG8_BAR; PG8_WAIT_L(0); PG8_MMA(0, 1, At, B1); PG8_BAR;
            PG8_LDA(At, 1, 1); PG8_STAGE(PG8_SA(1, 0), a3, voffA);
            PG8_BAR; PG8_WAIT_L(0); PG8_MMA(1, 0, At, B0); PG8_BAR; PG8_SCHED;
            PG8_STAGE(PG8_SB(1, 1), b3 + hstep, voffB);
            PG8_WAIT_V(6); PG8_BAR; PG8_MMA(1, 1, At, B1); PG8_BAR;
            }
        }
        if constexpr (ALIGN_EPI) { if (wr == 0) PG8_BAR; }
        if constexpr (!Epi::AFTER_DRAIN) {
            if constexpr (Epi::USE_RS) { if (has_next) E.rs_stage(nxt, tid, rsbuf + 256 * ((ui + 1) & 1)); }
            E(acc, cur, wr, wc, fr, fq, rsbuf + 256 * (ui & 1)); S.done(cur); }
        if (!has_next) break;
#pragma unroll
        for (int a = 0; a < 2; ++a)
#pragma unroll
            for (int b = 0; b < 2; ++b)
#pragma unroll
                for (int m = 0; m < 4; ++m)
#pragma unroll
                    for (int n = 0; n < 2; ++n) acc[a][b][m][n] = (f32x4){0.f, 0.f, 0.f, 0.f};
        cur = nxt; cA = nA; cB = nB; ++ui;
        if constexpr (ALIGN_EPI) { if (wr == 1) PG8_BAR; }
    }
    PG8_WAIT_V(0);
    if constexpr (!ALIGN_EPI) { if (wr == 0) PG8_BAR; }
    PG8_BAR;
    if constexpr (Epi::AFTER_DRAIN) { E.fused(acc, cur, wr, wc, fr, fq, lds, wid, lane); S.done(cur); }
#undef PG8_SA
#undef PG8_SB
#undef PG8_STAGE
#undef PG8_LDA
#undef PG8_LDB
#undef PG8_MMA
#undef PG8_WAIT_V
#undef PG8_WAIT_L
#undef PG8_BAR
#undef PG8_SCHED
}
}
#ifndef PG8_SP2
#define PG8_SP2 true
#endif
#ifndef PG8_ALIGN
#define PG8_ALIGN true
#endif
#define LAS __attribute__((address_space(3)))
typedef unsigned short bf16;
typedef float f32x4 __attribute__((ext_vector_type(4)));
typedef float f32x16 __attribute__((ext_vector_type(16)));
typedef short bf16x8 __attribute__((ext_vector_type(8)));
typedef short s16x4 __attribute__((ext_vector_type(4)));
typedef unsigned u32x4 __attribute__((ext_vector_type(4)));
typedef unsigned u32x2 __attribute__((ext_vector_type(2)));
using pg8::cvt_pk_bf16;
using pg8::Unit;

constexpr int TP = 16384, TS = 1024, T = TP + TS, D = 1024, FF = 2816, NIN = 4096, SEQ = 8192;
constexpr float LOG2E = 1.4426950408889634f;
constexpr float QSCALE = 0.125f * LOG2E;
constexpr float MQSCALE = 0.08838834764831845f * LOG2E;
constexpr float RMS_EPS = 1e-6f;

constexpr size_t MiB = 1u << 20;
constexpr size_t WS_CTL = 0, WS_WGU1 = 1 * MiB, WS_WD1 = 13 * MiB, WS_WIN = 19 * MiB, WS_WAB = 27 * MiB, WS_WOUT = 30 * MiB, WS_WMQ = 32 * MiB,
                 WS_WMKV = 33 * MiB, WS_WMO = 35 * MiB, WS_WGU2 = 36 * MiB, WS_WD2 = 48 * MiB, WS_ROPE = 54 * MiB, WS_SS1 = 55 * MiB, WS_SS2 = 57 * MiB,
                 WS_SS3 = 59 * MiB, WS_SS4 = 61 * MiB, WS_SS5 = 63 * MiB, WS_SSM = 65 * MiB, WS_MEMB = 66 * MiB, WS_MKB = 67 * MiB, WS_MVB = 68 * MiB,
                 WS_XB = 70 * MiB, WS_HB = 104 * MiB, WS_H = 138 * MiB, WS_ACT = 206 * MiB, WS_Z = 300 * MiB, WS_AB = 436 * MiB, WS_MIX = 462 * MiB,
                 WS_QM = 496 * MiB, WS_OM = 513 * MiB, WS_END = 530 * MiB;
constexpr size_t O_Y = 0, O_SWAKP = (size_t)T * D, O_SWAVP = O_SWAKP + 2 * 128 * 2 * 64, O_DILKP = O_SWAVP + 2 * 128 * 2 * 64, O_DILVP = O_DILKP + 2 * 2048 * 4 * 64,
                 O_MEMKP = O_DILVP + 2 * 2048 * 4 * 64, O_MEMVP = O_MEMKP + 2 * 256 * 512, O_SWAKS = O_MEMVP + 2 * 256 * 512, O_SWAVS = O_SWAKS + 1024 * 2 * 64,
                 O_DILKS = O_SWAVS + 1024 * 2 * 64, O_DILVS = O_DILKS + 1024 * 4 * 64, O_END = O_DILVS + 1024 * 4 * 64;
constexpr int LDS_BYTES = 147456;

struct Args { const float* in[30]; float* out; unsigned char* ws; int lo, hi; };

__device__ __forceinline__ float wave_sum(float v) {
#pragma unroll
    for (int o = 1; o < 64; o <<= 1) v += __shfl_xor(v, o);
    return v;
}
__device__ __forceinline__ float fexp2(float x) { return __builtin_amdgcn_exp2f(x); }
__device__ __forceinline__ float frcp(float x) { return __builtin_amdgcn_rcpf(x); }
__device__ __forceinline__ float bf2f(unsigned short b) { return __builtin_bit_cast(float, (unsigned)b << 16); }
__device__ __forceinline__ float row_rs(const float* ss, int row, int nrows = T) {
    const f32x4 a = *(const f32x4*)(ss + ((size_t)0 * nrows + row) * 4), b = *(const f32x4*)(ss + ((size_t)1 * nrows + row) * 4),
                c = *(const f32x4*)(ss + ((size_t)2 * nrows + row) * 4), d = *(const f32x4*)(ss + ((size_t)3 * nrows + row) * 4);
    const float s = (((a.x + a.y) + (a.z + a.w)) + ((b.x + b.y) + (b.z + b.w))) + (((c.x + c.y) + (c.z + c.w)) + ((d.x + d.y) + (d.z + d.w)));
    return rsqrtf(s * (1.0f / 1024.0f) + RMS_EPS);
}
__device__ __forceinline__ u32x4 pack8(const f32x4 a, const f32x4 b) {
    u32x4 w; w.x = cvt_pk_bf16(a.x, a.y); w.y = cvt_pk_bf16(a.z, a.w); w.z = cvt_pk_bf16(b.x, b.y); w.w = cvt_pk_bf16(b.z, b.w); return w;
}

struct EpiGU {
    static constexpr bool PERM = true, AFTER_DRAIN = false, USE_RS = true;
    bf16* act; const float* ss;
    __device__ __forceinline__ void rs_stage(const Unit& u, int tid, LAS float* buf) const { if (tid < 256) buf[tid] = row_rs(ss, u.pm * 256 + tid) * 1.0f; }
    __device__ __forceinline__ void operator()(const f32x4 (&acc)[2][2][4][2], const Unit& u, int wr, int wc, int fr, int fq, const LAS float* rsl) const {
        const int row0 = u.pm * 256 + wr * 64 + fr, col0 = u.pn * 128 + wc * 32 + 8 * fq;
#pragma unroll
        for (int ai = 0; ai < 2; ++ai)
#pragma unroll
            for (int m = 0; m < 4; ++m) {
                const int row = row0 + ai * 128 + m * 16; const float rs = rsl[ai * 128 + wr * 64 + m * 16 + fr];
                f32x4 o[2];
#pragma unroll
                for (int n = 0; n < 2; ++n)
#pragma unroll
                    for (int e = 0; e < 4; ++e) { const float g = acc[ai][0][m][n][e] * rs, up = acc[ai][1][m][n][e] * rs;
                        o[n][e] = g * frcp(1.0f + fexp2(-g * LOG2E)) * up; }
                *(u32x4*)(act + (size_t)row * FF + col0) = pack8(o[0], o[1]);
            }
    }
};
struct EpiRES {
    static constexpr bool PERM = true, AFTER_DRAIN = false, USE_RS = false;
    const float* res0; const float* res1; float* out; bf16* hb; float* ss; float alpha;
    __device__ __forceinline__ const float* rptr(int row, int col0) const { return (row < TP ? res0 + (size_t)row * D : res1 + (size_t)(row - TP) * D) + col0; }
    __device__ __forceinline__ void operator()(const f32x4 (&acc)[2][2][4][2], const Unit& u, int wr, int wc, int fr, int fq, const LAS float* rsl) const {
        const int row0 = u.pm * 256 + wr * 64 + fr, col0 = u.pn * 256 + wc * 32 + 8 * fq;
        f32x4 rn[4];
        { const float* rp = rptr(row0, col0); rn[0] = __builtin_nontemporal_load((const f32x4*)rp); rn[1] = __builtin_nontemporal_load((const f32x4*)(rp + 4)); rn[2] = __builtin_nontemporal_load((const f32x4*)(rp + 128)); rn[3] = __builtin_nontemporal_load((const f32x4*)(rp + 132)); }
#pragma unroll
        for (int ai = 0; ai < 2; ++ai)
#pragma unroll
            for (int m = 0; m < 4; ++m) {
                const int row = row0 + ai * 128 + m * 16;
                f32x4 rc[4];
#pragma unroll
                for (int i = 0; i < 4; ++i) rc[i] = rn[i];
                if (ai * 4 + m < 7) { const int nr = row0 + ((ai * 4 + m + 1) >> 2) * 128 + ((ai * 4 + m + 1) & 3) * 16; const float* rp = rptr(nr, col0);
                    rn[0] = __builtin_nontemporal_load((const f32x4*)rp); rn[1] = __builtin_nontemporal_load((const f32x4*)(rp + 4)); rn[2] = __builtin_nontemporal_load((const f32x4*)(rp + 128)); rn[3] = __builtin_nontemporal_load((const f32x4*)(rp + 132)); }
                float s = 0.f;
#pragma unroll
                for (int bj = 0; bj < 2; ++bj) {
                    const f32x4 v0 = rc[2 * bj] + acc[ai][bj][m][0] * alpha, v1 = rc[2 * bj + 1] + acc[ai][bj][m][1] * alpha;
                    float* op = out + (size_t)row * D + col0 + bj * 128;
                    *(f32x4*)op = v0; *(f32x4*)(op + 4) = v1;
                    if (hb) *(u32x4*)(hb + (size_t)row * D + col0 + bj * 128) = pack8(v0, v1);
                    s += (v0.x * v0.x + v0.y * v0.y) + (v0.z * v0.z + v0.w * v0.w) + (v1.x * v1.x + v1.y * v1.y) + (v1.z * v1.z + v1.w * v1.w);
                }
                s += __shfl_xor(s, 16); s += __shfl_xor(s, 32);
                if (fq == 0) __hip_atomic_store(ss + ((size_t)u.pn * T + row) * 4 + wc, s, __ATOMIC_RELAXED, __HIP_MEMORY_SCOPE_AGENT);
            }
    }
};
struct EpiMEMKV {
    static constexpr bool PERM = true, AFTER_DRAIN = false, USE_RS = true;
    float* ok; float* ov; bf16* kb; bf16* vb; const float* ss;
    __device__ __forceinline__ void rs_stage(const Unit& u, int tid, LAS float* buf) const { if (tid < 256) buf[tid] = row_rs(ss, u.pm * 256 + tid, 512) * 1.0f; }
    __device__ __forceinline__ void operator()(const f32x4 (&acc)[2][2][4][2], const Unit& u, int wr, int wc, int fr, int fq, const LAS float* rsl) const {
        const int row0 = u.pm * 256 + wr * 64 + fr, col0 = (u.pn & 1) * 256 + wc * 32 + 8 * fq;
        float* of = (u.pn < 2) ? ok : ov; bf16* ob = (u.pn < 2) ? kb : vb;
#pragma unroll
        for (int ai = 0; ai < 2; ++ai)
#pragma unroll
            for (int m = 0; m < 4; ++m) {
                const int row = row0 + ai * 128 + m * 16; const float rs = rsl[ai * 128 + wr * 64 + m * 16 + fr];
#pragma unroll
                for (int bj = 0; bj < 2; ++bj) {
                    const f32x4 v0 = acc[ai][bj][m][0] * rs, v1 = acc[ai][bj][m][1] * rs;
                    float* op = of + (size_t)row * 512 + col0 + bj * 128;
                    *(f32x4*)op = v0; *(f32x4*)(op + 4) = v1;
                    *(u32x4*)(ob + (size_t)row * 512 + col0 + bj * 128) = pack8(v0, v1);
                }
            }
    }
};
struct EpiQM {
    static constexpr bool PERM = true, AFTER_DRAIN = false, USE_RS = true;
    bf16* qm; const float* ss;
    __device__ __forceinline__ void rs_stage(const Unit& u, int tid, LAS float* buf) const { if (tid < 256) buf[tid] = row_rs(ss, u.pm * 256 + tid) * MQSCALE; }
    __device__ __forceinline__ void operator()(const f32x4 (&acc)[2][2][4][2], const Unit& u, int wr, int wc, int fr, int fq, const LAS float* rsl) const {
        const int row0 = u.pm * 256 + wr * 64 + fr, col0 = u.pn * 256 + wc * 32 + 8 * fq;
#pragma unroll
        for (int ai = 0; ai < 2; ++ai)
#pragma unroll
            for (int m = 0; m < 4; ++m) {
                const int row = row0 + ai * 128 + m * 16; const float rs = rsl[ai * 128 + wr * 64 + m * 16 + fr];
#pragma unroll
                for (int bj = 0; bj < 2; ++bj)
                    *(u32x4*)(qm + (size_t)row * 512 + col0 + bj * 128) = pack8(acc[ai][bj][m][0] * rs, acc[ai][bj][m][1] * rs);
            }
    }
};
struct EpiBRANCH {
    static constexpr bool PERM = true, AFTER_DRAIN = false, USE_RS = false;
    bf16* mixed; const bf16* Z;
    __device__ __forceinline__ void operator()(const f32x4 (&acc)[2][2][4][2], const Unit& u, int wr, int wc, int fr, int fq, const LAS float* rsl) const {
        const int row0 = u.pm * 256 + wr * 64 + fr, j0 = u.pn * 128 + wc * 32 + 8 * fq;
        bf16x8 gan = *(const bf16x8*)(Z + (size_t)row0 * NIN + 2048 + j0), gbn = *(const bf16x8*)(Z + (size_t)row0 * NIN + 3072 + j0);
#pragma unroll
        for (int ai = 0; ai < 2; ++ai)
#pragma unroll
            for (int m = 0; m < 4; ++m) {
                const int row = row0 + ai * 128 + m * 16;
                const bf16x8 ga = gan, gb = gbn;
                if (ai * 4 + m < 7) { const int nr = row0 + ((ai * 4 + m + 1) >> 2) * 128 + ((ai * 4 + m + 1) & 3) * 16;
                    gan = *(const bf16x8*)(Z + (size_t)nr * NIN + 2048 + j0); gbn = *(const bf16x8*)(Z + (size_t)nr * NIN + 3072 + j0); }
                f32x4 o[2];
#pragma unroll
                for (int n = 0; n < 2; ++n)
#pragma unroll
                    for (int e = 0; e < 4; ++e)
                        o[n][e] = bf2f((unsigned short)ga[4 * n + e]) * acc[ai][0][m][n][e] + bf2f((unsigned short)gb[4 * n + e]) * acc[ai][1][m][n][e];
                *(u32x4*)(mixed + (size_t)row * D + j0) = pack8(o[0], o[1]);
            }
    }
};
struct EpiZIN {
    static constexpr bool PERM = true, AFTER_DRAIN = false, USE_RS = true;
    bf16* Z; const float* ss; const float* rope; float* out;
    __device__ __forceinline__ void rs_stage(const Unit& u, int tid, LAS float* buf) const { if (tid < 256) buf[tid] = row_rs(ss, u.pm * 256 + tid) * 1.0f; }
    __device__ __forceinline__ void operator()(const f32x4 (&acc)[2][2][4][2], const Unit& u, int wr, int wc, int fr, int fq, const LAS float* rsl) const {
        const int row0 = u.pm * 256 + wr * 64 + fr;
#pragma unroll
        for (int bj = 0; bj < 2; ++bj) {
            const int cbase = u.pn * 256 + bj * 128 + wc * 32;
            const int c0 = cbase + 8 * fq;
            if (cbase >= 2048) {
#pragma unroll
                for (int ai = 0; ai < 2; ++ai)
#pragma unroll
                    for (int m = 0; m < 4; ++m) {
                        const int row = row0 + ai * 128 + m * 16; const float rs = rsl[ai * 128 + wr * 64 + m * 16 + fr];
                        f32x4 o[2];
#pragma unroll
                        for (int n = 0; n < 2; ++n)
#pragma unroll
                            for (int e = 0; e < 4; ++e) o[n][e] = frcp(1.0f + fexp2(-acc[ai][bj][m][n][e] * rs * LOG2E));
                        *(u32x4*)(Z + (size_t)row * NIN + c0) = pack8(o[0], o[1]);
                    }
            } else {
                const int slot = cbase >> 6, dimbase = cbase & 63;
                const bool is_v = (slot == 10) || (slot == 11) || (slot >= 28);
                const bool is_q = (slot < 8) || (slot >= 12 && slot < 24);
                const bool is_kv = !is_q;
                const bool do_rope = (!is_v) && (dimbase == 0);
                const float qs = is_q ? QSCALE : 1.0f;
                int nkv = 2, keep = 128, kvh = 0; size_t op_p = 0, op_s = 0;
                if (slot == 8 || slot == 9) { kvh = slot - 8; op_p = O_SWAKP; op_s = O_SWAKS; }
                else if (slot == 10 || slot == 11) { kvh = slot - 10; op_p = O_SWAVP; op_s = O_SWAVS; }
                else if (slot >= 24 && slot < 28) { kvh = slot - 24; nkv = 4; keep = 2048; op_p = O_DILKP; op_s = O_DILKS; }
                else if (slot >= 28) { kvh = slot - 28; nkv = 4; keep = 2048; op_p = O_DILVP; op_s = O_DILVS; }
#pragma unroll
                for (int ai = 0; ai < 2; ++ai)
#pragma unroll
                    for (int m = 0; m < 4; ++m) {
                        const int row = row0 + ai * 128 + m * 16; const float rs = rsl[ai * 128 + wr * 64 + m * 16 + fr];
                        f32x4 v[2]; v[0] = acc[ai][bj][m][0] * rs; v[1] = acc[ai][bj][m][1] * rs;
                        if (do_rope) {
                            f32x4 ot[2];
#pragma unroll
                            for (int n = 0; n < 2; ++n)
#pragma unroll
                                for (int e = 0; e < 4; ++e) ot[n][e] = __shfl_xor(v[n][e], 16);
                            if (fq < 2) {
                                const int pi = (row < TP) ? (row & (SEQ - 1)) : (SEQ + ((row - TP) & 7));
                                const f32x4* cs = (const f32x4*)(rope + (size_t)pi * 16);
                                const float sg = (fq == 0) ? -1.0f : 1.0f;
#pragma unroll
                                for (int n = 0; n < 2; ++n) {
                                    const f32x4 c01 = cs[2 * n], c23 = cs[2 * n + 1];
                                    v[n][0] = v[n][0] * c01.x + sg * ot[n][0] * c01.y;
                                    v[n][1] = v[n][1] * c01.z + sg * ot[n][1] * c01.w;
                                    v[n][2] = v[n][2] * c23.x + sg * ot[n][2] * c23.y;
                                    v[n][3] = v[n][3] * c23.z + sg * ot[n][3] * c23.w;
                                }
                            }
                        }
                        if (is_kv) {
                            float* op = nullptr;
                            if (row < TP) { const int b = row >> 13, s = row & (SEQ - 1);
                                if (s >= SEQ - keep) op = out + op_p + ((size_t)(b * keep + s - (SEQ - keep)) * nkv + kvh) * 64 + dimbase + 8 * fq; }
                            else op = out + op_s + ((size_t)(row - TP) * nkv + kvh) * 64 + dimbase + 8 * fq;
                            if (op) { *(f32x4*)op = v[0]; *(f32x4*)(op + 4) = v[1]; }
                        }
                        *(u32x4*)(Z + (size_t)row * NIN + c0) = pack8(v[0] * qs, v[1] * qs);
                    }
            }
        }
    }
};

template <bool F32> __device__ __forceinline__ bf16x8 ld8(const void* p, int eoff) {
    if constexpr (F32) { const f32x4* f = (const f32x4*)((const float*)p + eoff); const f32x4 a = f[0], b = f[1]; return __builtin_bit_cast(bf16x8, pack8(a, b)); }
    else return *(const bf16x8*)((const bf16*)p + eoff);
}
typedef short v4i16_t __attribute__((ext_vector_type(4)));
__device__ __forceinline__ s16x4 vtr(const LAS unsigned char* p) { return __builtin_bit_cast(s16x4, __builtin_amdgcn_ds_read_tr16_b64_v4i16((LAS v4i16_t*)p)); }
#define MFMA32(a, b, c) __builtin_amdgcn_mfma_f32_32x32x16_bf16((a), (b), (c), 0, 0, 0)

template <int DH, bool F32> struct RawKV;
template <int DH> struct RawKV<DH, false> {
    bf16x8 k[DH / 16], v[DH / 16];
    __device__ __forceinline__ void load(const void* krow, const void* vrow, int lane) {
        const int h = lane >> 5;
#pragma unroll
        for (int i = 0; i < DH / 16; ++i) { k[i] = *(const bf16x8*)((const bf16*)krow + 16 * i + 8 * h); v[i] = *(const bf16x8*)((const bf16*)vrow + (lane & 1) * (DH / 2) + 8 * i); }
    }
    __device__ __forceinline__ bf16x8 kf(int i) const { return k[i]; }
    __device__ __forceinline__ bf16x8 vf(int i) const { return v[i]; }
};
template <int DH> struct RawKV<DH, true> {
    f32x4 k[DH / 8], v[DH / 8];
    __device__ __forceinline__ void load(const void* krow, const void* vrow, int lane) {
        const int h = lane >> 5;
#pragma unroll
        for (int i = 0; i < DH / 16; ++i) {
            const f32x4* kp = (const f32x4*)((const float*)krow + 16 * i + 8 * h); k[2 * i] = kp[0]; k[2 * i + 1] = kp[1];
            const f32x4* vp = (const f32x4*)((const float*)vrow + (lane & 1) * (DH / 2) + 8 * i); v[2 * i] = vp[0]; v[2 * i + 1] = vp[1];
        }
    }
    __device__ __forceinline__ bf16x8 kf(int i) const { return __builtin_bit_cast(bf16x8, pack8(k[2 * i], k[2 * i + 1])); }
    __device__ __forceinline__ bf16x8 vf(int i) const { return __builtin_bit_cast(bf16x8, pack8(v[2 * i], v[2 * i + 1])); }
};
template <int DH> __device__ __forceinline__ void pack_kv(RawKV<DH, false>& d, const RawKV<DH, true>& s) {
#pragma unroll
    for (int i = 0; i < DH / 16; ++i) { d.k[i] = s.kf(i); d.v[i] = s.vf(i); }
}
template <int DH> struct Flash {
    static constexpr int VS = DH * 2 + 16;
    float m, l; f32x16 O[DH / 32];
    __device__ __forceinline__ void init() {
        m = -INFINITY; l = 0.f;
#pragma unroll
        for (int d = 0; d < DH / 32; ++d)
#pragma unroll
            for (int r = 0; r < 16; ++r) O[d][r] = 0.f;
    }
    __device__ __forceinline__ void loadq(bf16x8 (&qb)[DH / 16], const bf16* qrow, int h) const {
#pragma unroll
        for (int ks = 0; ks < DH / 16; ++ks) qb[ks] = ld8<false>(qrow, 16 * ks + 8 * h);
    }
    template <bool F32> __device__ __forceinline__ void step(const void* krow, const void* vrow, const bf16x8 (&qb)[DH / 16], unsigned vmask, LAS unsigned char* vl, int lane) {
        {   LAS unsigned char* dst = vl + (lane >> 1) * VS + (lane & 1) * DH;
#pragma unroll
            for (int k = 0; k < DH / 16; ++k) *(LAS bf16x8*)(dst + 16 * k) = ld8<F32>(vrow, (lane & 1) * (DH / 2) + 8 * k);
        }
        const int h = lane >> 5;
        f32x16 s;
#pragma unroll
        for (int r = 0; r < 16; ++r) s[r] = 0.f;
#pragma unroll
        for (int ks = 0; ks < DH / 16; ++ks) { const bf16x8 ka = ld8<F32>(krow, 16 * ks + 8 * h); s = MFMA32(ka, qb[ks], s); }
        float mx = -INFINITY;
#pragma unroll
        for (int r = 0; r < 16; ++r) { const float v = ((vmask >> r) & 1u) ? s[r] : -INFINITY; s[r] = v; mx = fmaxf(mx, v); }
        mx = fmaxf(mx, __shfl_xor(mx, 32));
        const float mn = fmaxf(m, mx), mu = (mn == -INFINITY) ? 0.f : mn;
        const float alpha = fexp2(m - mu);
        float ls = 0.f;
#pragma unroll
        for (int r = 0; r < 16; ++r) { const float p = fexp2(s[r] - mu); s[r] = p; ls += p; }
        l = l * alpha + ls;
        if (__any(mn != m)) {
#pragma unroll
            for (int d = 0; d < DH / 32; ++d)
#pragma unroll
                for (int r = 0; r < 16; ++r) O[d][r] *= alpha;
        }
        m = mn;
        bf16x8 pb[2];
#pragma unroll
        for (int s2 = 0; s2 < 2; ++s2) {
            u32x4 w; w.x = cvt_pk_bf16(s[8 * s2 + 0], s[8 * s2 + 1]); w.y = cvt_pk_bf16(s[8 * s2 + 2], s[8 * s2 + 3]);
            w.z = cvt_pk_bf16(s[8 * s2 + 4], s[8 * s2 + 5]); w.w = cvt_pk_bf16(s[8 * s2 + 6], s[8 * s2 + 7]);
            pb[s2] = __builtin_bit_cast(bf16x8, w);
        }
        asm volatile("" ::: "memory");
        const int i16 = lane & 15, q = i16 >> 2, p4 = i16 & 3, blk = (lane >> 4) & 1;
        const LAS unsigned char* vb = vl + (4 * h + q) * VS + (16 * blk + 4 * p4) * 2;
#pragma unroll
        for (int d = 0; d < DH / 32; ++d)
#pragma unroll
            for (int s2 = 0; s2 < 2; ++s2) {
                const s16x4 lo = vtr(vb + (16 * s2) * VS + d * 64), hi = vtr(vb + (16 * s2 + 8) * VS + d * 64);
                const bf16x8 va = __builtin_shufflevector(lo, hi, 0, 1, 2, 3, 4, 5, 6, 7);
                O[d] = MFMA32(va, pb[s2], O[d]);
            }
        asm volatile("" ::: "memory");
    }
    template <bool F32> __device__ __forceinline__ void step_raw(const RawKV<DH, F32>& kv, const bf16x8 (&qb)[DH / 16], unsigned vmask, LAS unsigned char* vl, int lane) {
        {   LAS unsigned char* dst = vl + (lane >> 1) * VS + (lane & 1) * DH;
#pragma unroll
            for (int k = 0; k < DH / 16; ++k) *(LAS bf16x8*)(dst + 16 * k) = kv.vf(k);
        }
        const int h = lane >> 5;
        f32x16 s;
#pragma unroll
        for (int r = 0; r < 16; ++r) s[r] = 0.f;
#pragma unroll
        for (int ks = 0; ks < DH / 16; ++ks) s = MFMA32(kv.kf(ks), qb[ks], s);
        float mx = -INFINITY;
#pragma unroll
        for (int r = 0; r < 16; ++r) { const float v = ((vmask >> r) & 1u) ? s[r] : -INFINITY; s[r] = v; mx = fmaxf(mx, v); }
        mx = fmaxf(mx, __shfl_xor(mx, 32));
        const float mn = fmaxf(m, mx), mu = (mn == -INFINITY) ? 0.f : mn;
        const float alpha = fexp2(m - mu);
        float ls = 0.f;
#pragma unroll
        for (int r = 0; r < 16; ++r) { const float p = fexp2(s[r] - mu); s[r] = p; ls += p; }
        l = l * alpha + ls;
        if (__any(mn != m)) {
#pragma unroll
            for (int d = 0; d < DH / 32; ++d)
#pragma unroll
                for (int r = 0; r < 16; ++r) O[d][r] *= alpha;
        }
        m = mn;
        bf16x8 pb[2];
#pragma unroll
        for (int s2 = 0; s2 < 2; ++s2) {
            u32x4 w; w.x = cvt_pk_bf16(s[8 * s2 + 0], s[8 * s2 + 1]); w.y = cvt_pk_bf16(s[8 * s2 + 2], s[8 * s2 + 3]);
            w.z = cvt_pk_bf16(s[8 * s2 + 4], s[8 * s2 + 5]); w.w = cvt_pk_bf16(s[8 * s2 + 6], s[8 * s2 + 7]);
            pb[s2] = __builtin_bit_cast(bf16x8, w);
        }
        asm volatile("" ::: "memory");
        const int i16 = lane & 15, q = i16 >> 2, p4 = i16 & 3, blk = (lane >> 4) & 1;
        const LAS unsigned char* vb = vl + (4 * h + q) * VS + (16 * blk + 4 * p4) * 2;
#pragma unroll
        for (int d = 0; d < DH / 32; ++d)
#pragma unroll
            for (int s2 = 0; s2 < 2; ++s2) {
                const s16x4 lo = vtr(vb + (16 * s2) * VS + d * 64), hi = vtr(vb + (16 * s2 + 8) * VS + d * 64);
                const bf16x8 va = __builtin_shufflevector(lo, hi, 0, 1, 2, 3, 4, 5, 6, 7);
                O[d] = MFMA32(va, pb[s2], O[d]);
            }
        asm volatile("" ::: "memory");
    }
    __device__ __forceinline__ float ltot() const { return l + __shfl_xor(l, 32); }
    __device__ __forceinline__ void write(bf16* dst, float inv, int h) const {
#pragma unroll
        for (int d = 0; d < DH / 32; ++d)
#pragma unroll
            for (int g = 0; g < 4; ++g) {
                u32x2 w; w.x = cvt_pk_bf16(O[d][4 * g] * inv, O[d][4 * g + 1] * inv); w.y = cvt_pk_bf16(O[d][4 * g + 2] * inv, O[d][4 * g + 3] * inv);
                *(u32x2*)(dst + 32 * d + 8 * g + 4 * h) = w;
            }
    }
};
__device__ __forceinline__ unsigned rows_to_vmask(unsigned rowmask, int h) { const unsigned x = rowmask >> (4 * h); return (x & 0xFu) | ((x >> 4) & 0xF0u) | ((x >> 8) & 0xF00u) | ((x >> 12) & 0xF000u); }
__device__ __forceinline__ unsigned range_mask(int lo, int hi) { lo = max(lo, 0); hi = min(hi, 31); return (lo <= hi) ? ((0xFFFFFFFFu >> (31 - hi)) & (0xFFFFFFFFu << lo)) : 0u; }
__device__ __forceinline__ int crow16(int r, int h) { return (r & 3) + 8 * (r >> 2) + 4 * h; }

__device__ __forceinline__ void task_pB(int tix, const bf16* Z, bf16* AB, LAS unsigned char* vl, int lane) {
    const int b = tix >> 10, kv = (tix >> 8) & 3, r = (tix >> 4) & 15, ub = tix & 15;
    const int c = lane & 31, h = lane >> 5;
    const int pq0 = r + 16 * (32 * ub), pq = pq0 + 16 * c;
    const bf16* Zb = Z + (size_t)(b * SEQ) * NIN;
    Flash<64> F; F.init();
    for (int g = 2; g >= 0; --g) {
        const int sh = 2 * g, nch = (g == 2) ? 5 : ((g == 1) ? 8 : 20);
        bf16x8 qb[4]; F.loadq(qb, Zb + (size_t)pq * NIN + 768 + (g * 4 + kv) * 64, h);
        const int kstart = pq0 - (128 << sh);
        int ch0 = 0;
        while (kstart + ((32 * ch0 + 31) << sh) < 0) ++ch0;
        const bf16* kbase = Zb + 1536 + kv * 64; const bf16* vbase = Zb + 1792 + kv * 64;
        RawKV<64, false> cur, nxt;
        { const int base = kstart + ((32 * ch0) << sh);
          cur.load(kbase + (size_t)min(max(base + (c << sh), 0), SEQ - 1) * NIN, vbase + (size_t)min(max(base + ((lane >> 1) << sh), 0), SEQ - 1) * NIN, lane); }
        for (int ch = ch0; ch < nch; ++ch) {
            const int base = kstart + ((32 * ch) << sh);
            { const int bn = kstart + ((32 * min(ch + 1, nch - 1)) << sh);
              nxt.load(kbase + (size_t)min(max(bn + (c << sh), 0), SEQ - 1) * NIN, vbase + (size_t)min(max(bn + ((lane >> 1) << sh), 0), SEQ - 1) * NIN, lane); }
            const int e_ = (pq - base) >> sh, i0_ = (base < 0) ? ((-base + (1 << sh) - 1) >> sh) : 0;
            const unsigned vmask = rows_to_vmask(range_mask(max(e_ - 128, i0_), e_), h);
            F.step_raw<false>(cur, qb, vmask, vl, lane);
            cur = nxt;
        }
    }
    const float inv = 1.0f / F.ltot();
    F.write(AB + (size_t)(b * SEQ + pq) * 768 + 512 + kv * 64, inv, h);
}
__device__ __forceinline__ void task_pA(int tix, const bf16* Z, bf16* AB, const float* sink, LAS unsigned char* vl, int lane) {
    const int b = tix >> 11, hd = (tix >> 8) & 7, tb = tix & 255, kv = hd >> 2;
    const int c = lane & 31, h = lane >> 5, pq = 32 * tb + c;
    const bf16* Zb = Z + (size_t)(b * SEQ) * NIN;
    Flash<64> F; F.init();
    bf16x8 qb[4]; F.loadq(qb, Zb + (size_t)pq * NIN + hd * 64, h);
    const int ch0 = (tb < 4) ? (4 - tb) : 0;
    const bf16* kbase = Zb + 512 + kv * 64; const bf16* vbase = Zb + 640 + kv * 64;
    RawKV<64, false> cur, nxt;
    { const int base = 32 * tb - 128 + 32 * ch0; cur.load(kbase + (size_t)max(base + c, 0) * NIN, vbase + (size_t)max(base + (lane >> 1), 0) * NIN, lane); }
    for (int ch = ch0; ch < 5; ++ch) {
        const int base = 32 * tb - 128 + 32 * ch;
        { const int bn = 32 * tb - 128 + 32 * min(ch + 1, 4); nxt.load(kbase + (size_t)max(bn + c, 0) * NIN, vbase + (size_t)max(bn + (lane >> 1), 0) * NIN, lane); }
        const unsigned vmask = rows_to_vmask(range_mask(max(pq - base - 128, -base), pq - base), h);
        F.step_raw<false>(cur, qb, vmask, vl, lane);
        cur = nxt;
    }
    const float inv = 1.0f / (F.ltot() + fexp2(sink[hd] * LOG2E - F.m));
    F.write(AB + (size_t)(b * SEQ + pq) * 768 + hd * 64, inv, h);
}
__device__ __forceinline__ const float* sA_row(const float* cache, const float* fresh, int b, int kv, int k) {
    const int kk = min(k, 135);
    return (kk < 128) ? cache + ((size_t)(b * 128 + kk) * 2 + kv) * 64 : fresh + ((size_t)(b * 8 + kk - 128) * 2 + kv) * 64;
}
__device__ __forceinline__ void task_sA(int tix, const bf16* Z, bf16* AB, const float* sink, const float* ck, const float* cv, const float* nk, const float* nv,
                                        LAS unsigned char* vl, int lane) {
    const int b = tix >> 1, kv = tix & 1;
    const int c = lane & 31, h = lane >> 5, t = c & 7, hd = kv * 4 + (c >> 3);
    const int row = TP + b * 8 + t;
    Flash<64> F; F.init();
    bf16x8 qb[4]; F.loadq(qb, Z + (size_t)row * NIN + hd * 64, h);
    RawKV<64, false> cur; RawKV<64, true> nxt;
    nxt.load(sA_row(ck, nk, b, kv, c), sA_row(cv, nv, b, kv, lane >> 1), lane); pack_kv<64>(cur, nxt);
    for (int ch = 0; ch < 5; ++ch) {
        { const int cn = min(ch + 1, 4); nxt.load(sA_row(ck, nk, b, kv, 32 * cn + c), sA_row(cv, nv, b, kv, 32 * cn + (lane >> 1)), lane); }
        const unsigned vmask = rows_to_vmask(range_mask(t - 32 * ch, 128 + t - 32 * ch), h);
        F.step_raw<false>(cur, qb, vmask, vl, lane);
        pack_kv<64>(cur, nxt);
    }
    const float inv = 1.0f / (F.ltot() + fexp2(sink[hd] * LOG2E - F.m));
    F.write(AB + (size_t)row * 768 + hd * 64, inv, h);
}
__device__ __forceinline__ int sB_kidx(int ch, int i) { return (ch < 24) ? 16 * (4 * ch + (i >> 3)) + (i & 7) : 1536 + 32 * (ch - 24) + i; }
__device__ __forceinline__ const float* sB_row(const float* cache, const float* fresh, int b, int kv, int k) {
    const int kk = min(k, 2055);
    return (kk < 2048) ? cache + ((size_t)(b * 2048 + kk) * 4 + kv) * 64 : fresh + ((size_t)(b * 8 + kk - 2048) * 4 + kv) * 64;
}
__device__ __forceinline__ void task_sB(int tix, const bf16* Z, bf16* AB, const float* ck, const float* cv, const float* nk, const float* nv, LAS unsigned char* vl, int lane) {
    const int b = tix >> 2, kv = tix & 3;
    const int c = lane & 31, h = lane >> 5, t = c & 7, g = c >> 3, ge = min(g, 2), sh = 2 * ge;
    const int row = TP + b * 8 + t;
    Flash<64> F; F.init();
    bf16x8 qb[4]; F.loadq(qb, Z + (size_t)row * NIN + 768 + (ge * 4 + kv) * 64, h);
    RawKV<64, false> cur; RawKV<64, true> nxt;
    nxt.load(sB_row(ck, nk, b, kv, sB_kidx(0, c)), sB_row(cv, nv, b, kv, sB_kidx(0, lane >> 1)), lane); pack_kv<64>(cur, nxt);
    for (int ch = 0; ch < 41; ++ch) {
        { const int cn = min(ch + 1, 40); nxt.load(sB_row(ck, nk, b, kv, sB_kidx(cn, c)), sB_row(cv, nv, b, kv, sB_kidx(cn, lane >> 1)), lane); }
        unsigned vmask;
        if (ch < 24) vmask = (g == 2 && h == (t >> 2)) ? (0x1111u << (t & 3)) : 0u;
        else { const int E = 512 + t - 32 * (ch - 24);
            const unsigned per = (sh == 0) ? 0xFFFFFFFFu : ((sh == 2) ? (0x11111111u << (t & 3)) : (0x00010001u << t));
            vmask = (g < 3) ? rows_to_vmask(range_mask(E - (128 << sh), E) & per, h) : 0u; }
        F.step_raw<false>(cur, qb, vmask, vl, lane);
        pack_kv<64>(cur, nxt);
    }
    const float lt = F.ltot();
    const int src = (lane & 32) + t;
    const float m0 = __shfl(F.m, src), m1 = __shfl(F.m, src + 8), m2 = __shfl(F.m, src + 16);
    const float l0 = __shfl(lt, src), l1 = __shfl(lt, src + 8), l2 = __shfl(lt, src + 16);
    const float M = fmaxf(m0, fmaxf(m1, m2));
    const float w0 = fexp2(m0 - M), w1 = fexp2(m1 - M), w2 = fexp2(m2 - M);
    const float inv = 1.0f / (w0 * l0 + w1 * l1 + w2 * l2);
#pragma unroll
    for (int d = 0; d < 2; ++d)
#pragma unroll
        for (int r = 0; r < 16; ++r) { const float o = F.O[d][r]; F.O[d][r] = w0 * __shfl(o, src) + w1 * __shfl(o, src + 8) + w2 * __shfl(o, src + 16); }
    if (g == 0) F.write(AB + (size_t)row * 768 + 512 + kv * 64, inv, h);
}
__device__ __forceinline__ void task_xP(int tix, const bf16* qm, const bf16* mkb, const bf16* mvb, bf16* om, LAS unsigned char* vl, int lane) {
    const int b = tix >> 10, hd = (tix >> 8) & 3, tile = tix & 255;
    const int c = lane & 31, h = lane >> 5, row = b * SEQ + 32 * tile + c;
    Flash<128> F; F.init();
    bf16x8 qb[8]; F.loadq(qb, qm + (size_t)row * 512 + hd * 128, h);
    for (int ch = 0; ch < 8; ++ch)
        F.step<false>(mkb + (size_t)(b * 256 + 32 * ch + c) * 512 + hd * 128, mvb + (size_t)(b * 256 + 32 * ch + (lane >> 1)) * 512 + hd * 128, qb, 0xffffu, vl, lane);
    const float inv = 1.0f / F.ltot();
    F.write(om + (size_t)row * 512 + hd * 128, inv, h);
}
__device__ __forceinline__ void task_xS(int tix, const bf16* qm, const float* ck, const float* cv, bf16* om, LAS unsigned char* vl, int lane) {
    const int b = tix >> 2, hd = tix & 3;
    const int c = lane & 31, h = lane >> 5, row = TP + b * 8 + (c & 7);
    Flash<128> F; F.init();
    bf16x8 qb[8]; F.loadq(qb, qm + (size_t)row * 512 + hd * 128, h);
    for (int ch = 0; ch < 8; ++ch)
        F.step<true>(ck + ((size_t)(b * 256 + 32 * ch + c) * 4 + hd) * 128, cv + ((size_t)(b * 256 + 32 * ch + (lane >> 1)) * 4 + hd) * 128, qb, 0xffffu, vl, lane);
    const float inv = 1.0f / F.ltot();
    if (c < 8) F.write(om + (size_t)row * 512 + hd * 128, inv, h);
}
__device__ __forceinline__ int next_task(unsigned* ctr, int lane) {
    int t = 0;
    if (lane == 0) t = (int)__hip_atomic_fetch_add(ctr, 1u, __ATOMIC_RELAXED, __HIP_MEMORY_SCOPE_AGENT);
    return __builtin_amdgcn_readfirstlane(t);
}

__device__ __forceinline__ void mini_gemm_res(const bf16* A, const bf16* Bt, int K, const float* res, float* out, bf16* hb, float* ss, float alpha, int unit, int wave, int lane,
                                              LAS float* red) {
    const int c = lane & 31, h = lane >> 5;
    const int row0 = TP + 32 * (unit >> 4) + c, cs = unit & 15, c0 = 64 * cs, kw = K >> 3;
    const bf16* ap0 = A + (size_t)row0 * K + wave * kw + 8 * h;
    const bf16* ap1 = ap0 + (size_t)512 * K;
    const bf16* b0 = Bt + (size_t)(c0 + c) * K + wave * kw + 8 * h;
    const bf16* b1 = b0 + (size_t)32 * K;
    f32x16 acc[2][2];
#pragma unroll
    for (int i = 0; i < 2; ++i)
#pragma unroll
        for (int j = 0; j < 2; ++j)
#pragma unroll
            for (int r = 0; r < 16; ++r) acc[i][j][r] = 0.f;
#pragma unroll 4
    for (int ks = 0; ks < kw; ks += 16) {
        const bf16x8 a0 = *(const bf16x8*)(ap0 + ks), a1 = *(const bf16x8*)(ap1 + ks), w0 = *(const bf16x8*)(b0 + ks), w1 = *(const bf16x8*)(b1 + ks);
        acc[0][0] = MFMA32(w0, a0, acc[0][0]); acc[0][1] = MFMA32(w1, a0, acc[0][1]);
        acc[1][0] = MFMA32(w0, a1, acc[1][0]); acc[1][1] = MFMA32(w1, a1, acc[1][1]);
    }
#pragma unroll
    for (int i = 0; i < 2; ++i)
#pragma unroll
        for (int j = 0; j < 2; ++j)
#pragma unroll
            for (int g = 0; g < 4; ++g)
                *(LAS f32x4*)(red + i * 16384 + ((wave * 8 + 4 * j + g) * 64 + lane) * 4) = (f32x4){acc[i][j][4 * g], acc[i][j][4 * g + 1], acc[i][j][4 * g + 2], acc[i][j][4 * g + 3]};
    __syncthreads();
    const int cb = wave >> 2, g = wave & 3;
#pragma unroll
    for (int i = 0; i < 2; ++i) {
        f32x4 sum = (f32x4){0.f, 0.f, 0.f, 0.f};
#pragma unroll
        for (int k = 0; k < 8; ++k) sum += *(const LAS f32x4*)(red + i * 16384 + ((k * 8 + wave) * 64 + lane) * 4);
        const size_t off = (size_t)(row0 + 512 * i) * D + c0 + 32 * cb + 8 * g + 4 * h;
        const f32x4 v = *(const f32x4*)(res + off) + sum * alpha;
        *(f32x4*)(out + off) = v;
        if (hb) { u32x2 w; w.x = cvt_pk_bf16(v.x, v.y); w.y = cvt_pk_bf16(v.z, v.w); *(u32x2*)(hb + off) = w; }
        red[32768 + i * 512 + wave * 64 + lane] = (v.x * v.x + v.y * v.y) + (v.z * v.z + v.w * v.w);
    }
    __syncthreads();
    if (wave < 2) {
        float t = 0.f;
#pragma unroll
        for (int k = 0; k < 8; ++k) t += red[32768 + wave * 512 + k * 64 + lane];
        t += __shfl_xor(t, 32);
        if (h == 0) __hip_atomic_store(ss + ((size_t)(cs >> 2) * T + row0 + 512 * wave) * 4 + (cs & 3), t, __ATOMIC_RELAXED, __HIP_MEMORY_SCOPE_AGENT);
    }
    __syncthreads();
}

__device__ __forceinline__ void tr_item(const float* W, int N, const float* gain, bf16* WT, int ldk, int koff, int blk, int blk_stride, int blk_off,
                                        LAS float* scr, int item, int lane) {
    const int nblk = N >> 5, kb = item / nblk, nb = item - kb * nblk, k0 = kb * 64, n0 = nb * 32;
    const int kr = lane >> 3, n4 = (lane & 7) * 4;
    f32x4 v[8]; float gs[8];
#pragma unroll
    for (int i = 0; i < 8; ++i) { v[i] = __builtin_nontemporal_load((const f32x4*)(W + (size_t)(k0 + 8 * i + kr) * N + n0 + n4)); gs[i] = gain ? gain[k0 + 8 * i + kr] : 1.0f; }
#pragma unroll
    for (int i = 0; i < 8; ++i) { LAS float* d = scr + (8 * i + kr) * 33 + n4; const f32x4 x = v[i] * gs[i]; d[0] = x.x; d[1] = x.y; d[2] = x.z; d[3] = x.w; }
    asm volatile("s_waitcnt lgkmcnt(0)" ::: "memory");
    const int c = lane & 7;
#pragma unroll
    for (int j = 0; j < 4; ++j) { const int n = (lane >> 3) + 8 * j; const LAS float* s = scr + (8 * c) * 33 + n;
        u32x4 o; o.x = cvt_pk_bf16(s[0 * 33], s[1 * 33]); o.y = cvt_pk_bf16(s[2 * 33], s[3 * 33]); o.z = cvt_pk_bf16(s[4 * 33], s[5 * 33]); o.w = cvt_pk_bf16(s[6 * 33], s[7 * 33]);
        const int nn = n0 + n, drow = (nn / blk) * blk_stride + blk_off + (nn % blk);
        *(u32x4*)(WT + (size_t)drow * ldk + koff + k0 + 8 * c) = o; }
    asm volatile("s_waitcnt lgkmcnt(0)" ::: "memory");
}
__device__ __forceinline__ void row_to_bf16(const float* xrow, bf16* orow, float* ss, int row, int nrows, int lane) {
    const f32x4* xr = (const f32x4*)xrow + lane;
    f32x4 v[4]; float s = 0.f;
#pragma unroll
    for (int j = 0; j < 4; ++j) { v[j] = __builtin_nontemporal_load(xr + 64 * j); s += (v[j].x * v[j].x + v[j].y * v[j].y) + (v[j].z * v[j].z + v[j].w * v[j].w); }
    s = wave_sum(s);
    u32x2* o8 = (u32x2*)orow + lane;
#pragma unroll
    for (int j = 0; j < 4; ++j) { u32x2 w; w.x = cvt_pk_bf16(v[j].x, v[j].y); w.y = cvt_pk_bf16(v[j].z, v[j].w); o8[64 * j] = w; }
    if (lane < 16) __hip_atomic_store(ss + ((size_t)(lane >> 2) * nrows + row) * 4 + (lane & 3), (lane == 0) ? s : 0.f, __ATOMIC_RELAXED, __HIP_MEMORY_SCOPE_AGENT);
}
__device__ __forceinline__ void sincos_d(double r, float& c, float& s) {
    const double r2 = r * r;
    double sc = 1.0, ss = 1.0;
    double tc = 1.0, ts = 1.0;
#pragma unroll
    for (int k = 1; k <= 14; ++k) { tc *= -r2 / (double)((2 * k - 1) * (2 * k)); ts *= -r2 / (double)((2 * k) * (2 * k + 1)); sc += tc; ss += ts; }
    c = (float)sc; s = (float)(ss * r);
}

#define XB_TMO      128
#define XB_XCNT(j)  (256  + 64 * (j))
#define XB_XSUB(j)  (1280 + 64 * (j))
#define XB_XGEN(j)  (2304 + 64 * (j))
#define XB_TOP      3328
#define XB_TOPGEN   3392
#define XCD_BAR_WORDS 3456
#define XB_SPIN_CAP (1u << 18)

__device__ __forceinline__ unsigned xb_ld(unsigned* p)              { return __hip_atomic_load(p, __ATOMIC_RELAXED, __HIP_MEMORY_SCOPE_AGENT); }
__device__ __forceinline__ unsigned xb_add(unsigned* p, unsigned v) { return __hip_atomic_fetch_add(p, v, __ATOMIC_RELAXED, __HIP_MEMORY_SCOPE_AGENT); }
__device__ __forceinline__ unsigned xb_xcc_id() { return (unsigned)__builtin_amdgcn_s_getreg((3 << 11) | 20) & 0xFu; }
#define XB_SPIN(cond, bar) do { unsigned _sp = 0; while (cond) { __builtin_amdgcn_s_sleep(1); \
    if ((++_sp & 255u) == 0u) { if (xb_ld(&(bar)[XB_TMO])) break; if (_sp > XB_SPIN_CAP) { atomicAdd(&(bar)[XB_TMO], 1u); break; } } } } while (0)

struct XcdBarrier {
    unsigned* bar; unsigned x;
    volatile LAS unsigned* st;
};

__device__ __forceinline__ XcdBarrier xcd_barrier_post(unsigned* bar, volatile LAS unsigned* st, bool t0) {
    XcdBarrier b; b.bar = bar; b.x = xb_xcc_id(); b.st = st;
    if (t0) (void)xb_add(&bar[XB_XCNT(b.x)], 1u);
    return b;
}
__device__ __forceinline__ void xcd_barrier_complete(unsigned* bar, unsigned x, unsigned& nloc, unsigned& nx) {
    const unsigned G = gridDim.x * gridDim.y * gridDim.z;
    unsigned sum, cnt, mine, sp = 0u;
    for (;;) {
        sum = 0u; cnt = 0u; mine = 0u;
#pragma unroll
        for (unsigned j = 0; j < 16; ++j) { const unsigned c = xb_ld(&bar[XB_XCNT(j)]); sum += c; cnt += (c > 0u) ? 1u : 0u; mine = (j == x) ? c : mine; }
        if (sum == G) break;
        __builtin_amdgcn_s_sleep(1);
        if ((++sp & 255u) == 0u) { if (xb_ld(&bar[XB_TMO])) break; if (sp > XB_SPIN_CAP) { atomicAdd(&bar[XB_TMO], 1u); break; } }
    }
    nloc = mine > 0u ? mine : 1u; nx = cnt > 0u ? cnt : 1u;
}

__device__ __forceinline__ void xcd_barrier(const XcdBarrier& b, bool t0) {
    asm volatile("s_waitcnt vmcnt(0)" ::: "memory");
    __syncthreads();
    if (t0) {
        unsigned* bar = b.bar;
        __builtin_amdgcn_s_waitcnt(0);
        unsigned nloc = b.st[0], nx = b.st[1];
        if (nloc == 0u) { xcd_barrier_complete(bar, b.x, nloc, nx); b.st[0] = nloc; b.st[1] = nx; }
        const unsigned old = xb_add(&bar[XB_XSUB(b.x)], 1u);
        const unsigned gen = old / nloc;
        if (old + 1u == (gen + 1u) * nloc) {
            __builtin_amdgcn_fence(__ATOMIC_RELEASE, "agent");
            asm volatile("s_waitcnt vmcnt(0)" ::: "memory");
            const unsigned og = xb_add(&bar[XB_TOP], 1u);
            const unsigned tg = og / nx;
            if (og + 1u == (tg + 1u) * nx) xb_add(&bar[XB_TOPGEN], 1u);
            else XB_SPIN(xb_ld(&bar[XB_TOPGEN]) == tg, bar);
            __builtin_amdgcn_fence(__ATOMIC_ACQUIRE, "agent");
            xb_add(&bar[XB_XGEN(b.x)], 1u);
            asm volatile("s_waitcnt vmcnt(0)" ::: "memory");
        } else {
            XB_SPIN(xb_ld(&bar[XB_XGEN(b.x)]) == gen, bar);
            __builtin_amdgcn_fence(__ATOMIC_ACQUIRE, "agent");
            asm volatile("s_waitcnt vmcnt(0)" ::: "memory");
        }
    }
    __syncthreads();
}

#ifndef REP_P0
#define REP_P0 1
#endif
#ifndef REP_GEMM
#define REP_GEMM 1
#endif
#ifndef REP_SYNC
#define REP_SYNC 1
#endif
#define CG_SYNC() do { asm volatile("s_waitcnt vmcnt(0)" ::: "memory"); grid.sync(); \
    if (wave == 0) { __builtin_amdgcn_fence(__ATOMIC_ACQUIRE, "agent"); asm volatile("s_waitcnt vmcnt(0)" ::: "memory"); } __syncthreads(); } while (0)
#define GRID_SYNC() for (int rs_ = 0; rs_ < REP_SYNC; ++rs_) do { XcdBarrier xb_; xb_.bar = (unsigned*)(a.ws + WS_CTL) + 1024; xb_.x = xb_xcc_id(); xb_.st = (volatile LAS unsigned*)(lds + 147200); \
    xcd_barrier(xb_, wave == 0 && lane_id() == 0); } while (0)
#define WSP(type, off) ((type*)(ws + (off)))
#define ctl WSP(unsigned, WS_CTL)
#define WGU1 WSP(bf16, WS_WGU1)
#define WD1 WSP(bf16, WS_WD1)
#define WIN WSP(bf16, WS_WIN)
#define WAB WSP(bf16, WS_WAB)
#define WOUT WSP(bf16, WS_WOUT)
#define WMQ WSP(bf16, WS_WMQ)
#define WMKV WSP(bf16, WS_WMKV)
#define WMO WSP(bf16, WS_WMO)
#define WGU2 WSP(bf16, WS_WGU2)
#define WD2 WSP(bf16, WS_WD2)
#define ROPE WSP(float, WS_ROPE)
#define SS1 WSP(float, WS_SS1)
#define SS2 WSP(float, WS_SS2)
#define SS3 WSP(float, WS_SS3)
#define SS4 WSP(float, WS_SS4)
#define SS5 WSP(float, WS_SS5)
#define SSM WSP(float, WS_SSM)
#define MEMB WSP(bf16, WS_MEMB)
#define MKB WSP(bf16, WS_MKB)
#define MVB WSP(bf16, WS_MVB)
#define XB WSP(bf16, WS_XB)
#define HB WSP(bf16, WS_HB)
#define H WSP(float, WS_H)
#define ACT WSP(bf16, WS_ACT)
#define Z WSP(bf16, WS_Z)
#define AB WSP(bf16, WS_AB)
#define MIX WSP(bf16, WS_MIX)
#define QM WSP(bf16, WS_QM)
#define OM WSP(bf16, WS_OM)
#define PHASE_PTRS unsigned char* ws; float* out; { unsigned long long w_ = (unsigned long long)a.ws, o_ = (unsigned long long)a.out; asm volatile("" : "+s"(w_), "+s"(o_)); ws = (unsigned char*)(__attribute__((address_space(1))) unsigned char*)w_; out = (float*)(__attribute__((address_space(1))) float*)o_; }
#define IN(k) (a.lo <= (k) && (k) < a.hi)
__global__ void __launch_bounds__(512, 2) fwd(Args a) {
    extern __shared__ __attribute__((aligned(16))) unsigned char lds_raw[];
    LAS unsigned char* lds = (LAS unsigned char*)lds_raw;
    cg::grid_group grid = cg::this_grid();
    const int wave = __builtin_amdgcn_readfirstlane(threadIdx.x >> 6);
    const int G = gridDim.x, bid = blockIdx.x;
    {
        const bool t0 = (wave == 0 && lane_id() == 0);
        if (t0) { ((volatile LAS unsigned*)(lds + 147200))[0] = 0u; ((volatile LAS unsigned*)(lds + 147200))[1] = 0u; }
        __syncthreads();
        (void)xcd_barrier_post((unsigned*)(a.ws + WS_CTL) + 1024, (volatile LAS unsigned*)(lds + 147200), t0);
    }
    const int gw = bid * 8 + wave, NGW = G * 8;

    if (IN(0)) for (int rp_ = 0; rp_ < REP_P0; ++rp_) {
        PHASE_PTRS
        const int lane = lane_id(), tid = wave * 64 + lane;
        LAS float* scr = (LAS float*)(lds + wave * 16384);
        constexpr int NI = 12416;
        for (int it = gw; it < NI; it += NGW) {
            int r = it;
            if (r < 1408) { tr_item(a.in[10], FF, a.in[9], WGU1, D, 0, 128, 256, 0, scr, r, lane); continue; } r -= 1408;
            if (r < 1408) { tr_item(a.in[11], FF, a.in[9], WGU1, D, 0, 128, 256, 128, scr, r, lane); continue; } r -= 1408;
            if (r < 1408) { tr_item(a.in[12], D, nullptr, WD1, FF, 0, D, 0, 0, scr, r, lane); continue; } r -= 1408;
            if (r < 2048) { tr_item(a.in[14], NIN, a.in[13], WIN, D, 0, NIN, 0, 0, scr, r, lane); continue; } r -= 2048;
            if (r < 256) { tr_item(a.in[16], D, nullptr, WAB, 768, 0, 128, 256, 0, scr, r, lane); continue; } r -= 256;
            if (r < 128) { tr_item(a.in[17], D, nullptr, WAB, 768, 512, 128, 256, 128, scr, r, lane); continue; } r -= 128;
            if (r < 512) { tr_item(a.in[18], D, nullptr, WOUT, D, 0, D, 0, 0, scr, r, lane); continue; } r -= 512;
            if (r < 256) { tr_item(a.in[21], 512, a.in[19], WMQ, D, 0, 512, 0, 0, scr, r, lane); continue; } r -= 256;
            if (r < 256) { tr_item(a.in[22], 512, a.in[20], WMKV, D, 0, 512, 0, 0, scr, r, lane); continue; } r -= 256;
            if (r < 256) { tr_item(a.in[23], 512, a.in[20], WMKV, D, 0, 512, 0, 512, scr, r, lane); continue; } r -= 256;
            if (r < 256) { tr_item(a.in[24], D, nullptr, WMO, 512, 0, D, 0, 0, scr, r, lane); continue; } r -= 256;
            if (r < 1408) { tr_item(a.in[26], FF, a.in[25], WGU2, D, 0, 128, 256, 0, scr, r, lane); continue; } r -= 1408;
            if (r < 1408) { tr_item(a.in[27], FF, a.in[25], WGU2, D, 0, 128, 256, 128, scr, r, lane); continue; } r -= 1408;
            tr_item(a.in[28], D, nullptr, WD2, FF, 0, D, 0, 0, scr, r, lane);
        }
        for (int idx = bid * 512 + tid; idx < 2048 * 96; idx += G * 512) {
            const int row = idx / 96, k = (idx - row * 96) * 8; const bool isA = (row & 255) < 128;
            if (isA ? (k >= 512) : (k < 512)) *(u32x4*)(WAB + (size_t)row * 768 + k) = (u32x4){0u, 0u, 0u, 0u};
        }
        for (int m = gw; m < T; m += NGW) row_to_bf16(m < TP ? a.in[0] + (size_t)m * D : a.in[1] + (size_t)(m - TP) * D, XB + (size_t)m * D, SS1, m, T, lane);
        for (int m = gw; m < 512; m += NGW) row_to_bf16(a.in[8] + (size_t)m * D, MEMB + (size_t)m * D, SSM, m, 512, lane);
        for (int idx = bid * 512 + tid; idx < 8200 * 8; idx += G * 512) {
            const int pi = idx >> 3, i = idx & 7; const int pos = (pi < SEQ) ? pi : pi + SEQ;
            const float invf[8] = {1.0f, 0.1939227432012558f, 0.03760603070259094f, 0.007292664609849453f, 0.0014142135623842478f, 0.00027424818836152554f, 5.318296098266728e-05f, 1.0313386155758053e-05f};
            float fr_ = 1.0f;
#pragma unroll
            for (int q = 0; q < 8; ++q) if (i == q) fr_ = invf[q];
            const float ang = (float)pos * fr_;
            const double ad = (double)ang, qd = __builtin_rint(ad * 0.15915494309189535), rd = ad - qd * 6.283185307179586;
            float cc, sn; sincos_d(rd, cc, sn);
            ROPE[(size_t)idx * 2] = cc; ROPE[(size_t)idx * 2 + 1] = sn;
        }
    }
    if (IN(0) && IN(1)) GRID_SYNC();
    if (a.lo > 64) CG_SYNC();
    if (IN(1)) {
        PHASE_PTRS
        pg8::Gemm g{XB, WGU1, T, 2 * FF, D}; pg8::StaticOrder S; S.init(T, 2 * FF, G, bid);
        EpiGU E{ACT, SS1};
        for (int rg_ = 0; rg_ < REP_GEMM; ++rg_) pg8::gemm_phase<EpiGU, pg8::StaticOrder, PG8_ALIGN, PG8_SP2>(lds, g, S, E, wave, (LAS float*)(lds + 131072));
        pg8::Gemm g2{MEMB, WMKV, 512, 1024, D}; pg8::StaticOrder S2; S2.init(512, 1024, G, G - 1 - bid);
        EpiMEMKV E2{out + O_MEMKP, out + O_MEMVP, MKB, MVB, SSM};
        for (int rg_ = 0; rg_ < REP_GEMM; ++rg_) pg8::gemm_phase<EpiMEMKV, pg8::StaticOrder, PG8_ALIGN, PG8_SP2>(lds, g2, S2, E2, wave, (LAS float*)(lds + 131072));
    }
    if (IN(1) && IN(2)) GRID_SYNC();
    if (IN(2)) {
        PHASE_PTRS
        pg8::Gemm g{ACT, WD1, TP, D, FF}; pg8::StaticOrder S; S.init(TP, D, G, bid);
        EpiRES E{a.in[0], a.in[1], H, HB, SS2, 0.5f};
        for (int rg_ = 0; rg_ < REP_GEMM; ++rg_) pg8::gemm_phase<EpiRES, pg8::StaticOrder, PG8_ALIGN, PG8_SP2>(lds, g, S, E, wave, (LAS float*)(lds + 131072));
        for (int u_ = bid; u_ < 256; u_ += G) mini_gemm_res(ACT, WD1, 2816, a.in[1] - (size_t)TP * D, H, HB, SS2, 0.5f, u_, wave, lane_id(), (LAS float*)lds);
    }
    if (IN(2) && IN(3)) GRID_SYNC();
    if (IN(3)) {
        PHASE_PTRS
        pg8::Gemm g{HB, WIN, T, NIN, D}; pg8::StaticOrder S; S.init(T, NIN, G, bid);
        EpiZIN E{Z, SS2, ROPE, out};
        for (int rg_ = 0; rg_ < REP_GEMM; ++rg_) pg8::gemm_phase<EpiZIN, pg8::StaticOrder, PG8_ALIGN, PG8_SP2>(lds, g, S, E, wave, (LAS float*)(lds + 131072));
    }
    if (IN(3) && IN(4)) GRID_SYNC();
    if (IN(4)) {
        PHASE_PTRS
        const int lane = lane_id();
        LAS unsigned char* vl = lds + wave * 8704;
#ifndef REP_ATTN
#define REP_ATTN 1
#endif
        const int x0 = (int)(xb_xcc_id() & 7u);
        for (int k = 0; k < 8; ++k) {
            const int x = (x0 + k) & 7;
            for (;;) {
                const int j = next_task(ctl + 64 * x, lane);
                if (j >= 864) break;
                if (j < 64) task_sB(64 * x + j, Z, AB, a.in[4], a.in[5], out + O_DILKS, out + O_DILVS, vl, lane);
                else if (j < 320) task_pB((x << 8) | (j - 64), Z, AB, vl, lane);
                else if (j < 352) task_sA(32 * x + (j - 320), Z, AB, a.in[15], a.in[2], a.in[3], out + O_SWAKS, out + O_SWAVS, vl, lane);
                else { const int jj = j - 352, hd = ((x >> 1) & 1) * 4 + (x & 1) * 2 + (jj >> 8);
                    task_pA(((x >> 2) << 11) | (hd << 8) | (jj & 255), Z, AB, a.in[15], vl, lane); }
            }
        }
    }
    if (IN(4) && IN(5)) GRID_SYNC();
    if (IN(5)) {
        PHASE_PTRS
        pg8::Gemm g{AB, WAB, T, 2048, 768}; pg8::StaticOrder S; S.init(T, 2048, G, bid);
        EpiBRANCH E{MIX, Z};
        for (int rg_ = 0; rg_ < REP_GEMM; ++rg_) pg8::gemm_phase<EpiBRANCH, pg8::StaticOrder, PG8_ALIGN, PG8_SP2>(lds, g, S, E, wave, (LAS float*)(lds + 131072));
    }
    if (IN(5) && IN(6)) GRID_SYNC();
    if (IN(6)) {
        PHASE_PTRS
        pg8::Gemm g{MIX, WOUT, TP, D, D}; pg8::StaticOrder S; S.init(TP, D, G, bid);
        EpiRES E{H, H + (size_t)TP * D, H, HB, SS3, 1.0f};
        pg8::gemm_phase<EpiRES, pg8::StaticOrder, PG8_ALIGN, PG8_SP2>(lds, g, S, E, wave, (LAS float*)(lds + 131072));
        for (int u_ = bid; u_ < 256; u_ += G) mini_gemm_res(MIX, WOUT, 1024, H, H, HB, SS3, 1.0f, u_, wave, lane_id(), (LAS float*)lds);
    }
    if (IN(6) && IN(7)) GRID_SYNC();
    if (IN(7)) {
        PHASE_PTRS
        pg8::Gemm g{HB, WMQ, T, 512, D}; pg8::StaticOrder S; S.init(T, 512, G, bid);
        EpiQM E{QM, SS3};
        for (int rg_ = 0; rg_ < REP_GEMM; ++rg_) pg8::gemm_phase<EpiQM, pg8::StaticOrder, PG8_ALIGN, PG8_SP2>(lds, g, S, E, wave, (LAS float*)(lds + 131072));
    }
    if (IN(7) && IN(8)) GRID_SYNC();
    if (IN(8)) {
        PHASE_PTRS
        const int lane = lane_id();
        LAS unsigned char* vl = lds + wave * 8704;
        for (int rep = 0; rep < REP_ATTN; ++rep)
        for (;;) {
            const int t = next_task(ctl + 512 + 128 * rep, lane);
            if (t >= 2560) break;
            if (t < 512) task_xS(t, QM, a.in[6], a.in[7], OM, vl, lane);
            else task_xP(t - 512, QM, MKB, MVB, OM, vl, lane);
        }
    }
    if (IN(8) && IN(9)) GRID_SYNC();
    if (IN(9)) {
        PHASE_PTRS
        pg8::Gemm g{OM, WMO, TP, D, 512}; pg8::StaticOrder S; S.init(TP, D, G, bid);
        EpiRES E{H, H + (size_t)TP * D, H, HB, SS4, 1.0f};
        pg8::gemm_phase<EpiRES, pg8::StaticOrder, PG8_ALIGN, PG8_SP2>(lds, g, S, E, wave, (LAS float*)(lds + 131072));
        for (int u_ = bid; u_ < 256; u_ += G) mini_gemm_res(OM, WMO, 512, H, H, HB, SS4, 1.0f, u_, wave, lane_id(), (LAS float*)lds);
    }
    if (IN(9) && IN(10)) GRID_SYNC();
    if (IN(10)) {
        PHASE_PTRS
        pg8::Gemm g{HB, WGU2, T, 2 * FF, D}; pg8::StaticOrder S; S.init(T, 2 * FF, G, bid);
        EpiGU E{ACT, SS4};
        for (int rg_ = 0; rg_ < REP_GEMM; ++rg_) pg8::gemm_phase<EpiGU, pg8::StaticOrder, PG8_ALIGN, PG8_SP2>(lds, g, S, E, wave, (LAS float*)(lds + 131072));
    }
    if (IN(10) && IN(11)) GRID_SYNC();
    if (IN(11)) {
        PHASE_PTRS
        pg8::Gemm g{ACT, WD2, TP, D, FF}; pg8::StaticOrder S; S.init(TP, D, G, bid);
        EpiRES E{H, H + (size_t)TP * D, H, nullptr, SS5, 0.5f};
        pg8::gemm_phase<EpiRES, pg8::StaticOrder, PG8_ALIGN, PG8_SP2>(lds, g, S, E, wave, (LAS float*)(lds + 131072));
        for (int u_ = bid; u_ < 256; u_ += G) mini_gemm_res(ACT, WD2, 2816, H, H, (bf16*)nullptr, SS5, 0.5f, u_, wave, lane_id(), (LAS float*)lds);
    }
    if (IN(11) && IN(12)) GRID_SYNC();
    if (IN(12)) for (int rp_ = 0; rp_ < REP_P0; ++rp_) {
        PHASE_PTRS
        const int lane = lane_id();
        const f32x4* gn = (const f32x4*)a.in[29] + lane;
        f32x4 gv[4];
#pragma unroll
        for (int j = 0; j < 4; ++j) gv[j] = gn[64 * j];
        for (int m = gw; m < T; m += NGW) {
            const f32x4* hr = (const f32x4*)(H + (size_t)m * D) + lane;
            f32x4 v[4]; float s = 0.f;
#pragma unroll
            for (int j = 0; j < 4; ++j) { v[j] = hr[64 * j]; s += (v[j].x * v[j].x + v[j].y * v[j].y) + (v[j].z * v[j].z + v[j].w * v[j].w); }
            const float rs = rsqrtf(wave_sum(s) * (1.0f / 1024.0f) + RMS_EPS);
            f32x4* yr = (f32x4*)(out + O_Y + (size_t)m * D) + lane;
#pragma unroll
            for (int j = 0; j < 4; ++j) __builtin_nontemporal_store(v[j] * rs * gv[j], yr + 64 * j);
        }
    }
}

extern "C" void kernel_launch(void* const* d_in, const int* in_sizes, int n_in, void* d_out, int out_size, void* d_ws, size_t ws_size, hipStream_t stream) {
    static int grid = 0;
    if (grid == 0) {
        if (n_in != 30 || (size_t)out_size != O_END || ws_size < WS_END) { fprintf(stderr, "kernel_launch: unexpected problem shape (n_in %d, out %d, ws %zu)\n", n_in, out_size, ws_size); grid = -1; return; }
        int dev = 0, cus = 0, per_cu = 0;
        hipGetDevice(&dev);
        hipDeviceGetAttribute(&cus, hipDeviceAttributeMultiprocessorCount, dev);
        hipFuncSetAttribute((const void*)fwd, hipFuncAttributeMaxDynamicSharedMemorySize, LDS_BYTES);
        hipOccupancyMaxActiveBlocksPerMultiprocessor(&per_cu, (const void*)fwd, 512, LDS_BYTES);
        if (per_cu < 1) { fprintf(stderr, "kernel_launch: occupancy query says %d blocks per CU\n", per_cu); per_cu = 1; }
        (void)hipGetLastError();
        grid = cus * per_cu;
    }
    if (grid < 0) return;
    hipMemsetAsync((char*)d_ws + WS_CTL, 0, 32768, stream);
    Args a{};
    for (int i = 0; i < 30; ++i) a.in[i] = (const float*)d_in[i];
    a.out = (float*)d_out; a.ws = (unsigned char*)d_ws;
#ifndef NLAUNCH
#define NLAUNCH 1
#endif
    for (int li = 0; li < NLAUNCH; ++li) {
        a.lo = (NLAUNCH == 1) ? 0 : li; a.hi = (NLAUNCH == 1) ? 13 : li + 1;
        void* args[] = {&a};
        hipError_t e = hipLaunchCooperativeKernel((const void*)fwd, dim3(grid), dim3(512), args, LDS_BYTES, stream);
        if (e != hipSuccess) { fprintf(stderr, "cooperative launch failed: %s (grid %d)\n", hipGetErrorString(e), grid); break; }
    }
}
```

```cpp
#include <hip/hip_runtime.h>
#include <hip/hip_cooperative_groups.h>
#include <cstdio>
#include <cstdint>
namespace cg = cooperative_groups;
__device__ __forceinline__ int lane_id() { int l; asm volatile("v_mbcnt_lo_u32_b32 %0, -1, 0\n\tv_mbcnt_hi_u32_b32 %0, -1, %0" : "=v"(l)); return l; }
namespace pg8 {
#define PG8_LAS __attribute__((address_space(3)))
typedef unsigned short bf16_t;
typedef short bf16x8 __attribute__((ext_vector_type(8)));
typedef float f32x4 __attribute__((ext_vector_type(4)));
typedef unsigned u32x4 __attribute__((ext_vector_type(4)));
constexpr int BM = 256, BK = 64, HALF = 128, HTB = HALF * BK * 2  , STAGE_BYTES = 8 * HTB, NXCD = 8, WGM = 8;

__host__ __device__ __forceinline__ int lds_byte(int r, int c) { const int st = (r >> 4) * 2 + (c >> 5), rr = r & 15, cc = c & 31, ob = rr * 64 + cc * 2; return st * 1024 + (ob ^ (((ob >> 9) & 1) << 5)); }
__host__ __device__ __forceinline__ void stage_rc(int b, int& R, int& C) { const int st = b / 1024, sb = b % 1024, swz = sb ^ (((sb >> 9) & 1) << 5); R = (st >> 1) * 16 + swz / 64; C = (st & 1) * 32 + (swz % 64) / 2; }
__host__ __device__ __forceinline__ int perm32(int rho) { const int n = rho >> 4, i = rho & 15; return 8 * (i >> 2) + 4 * n + (i & 3); }

struct Unit { int pm, pn; };
struct Gemm { const bf16_t* A; const bf16_t* Bt; int M, N, K; };

struct StaticOrder {
    int nM, nN, nwg, G, c;
    __host__ __device__ void init(int M, int N, int G_, int c_) { nM = M / BM; nN = N / BM; nwg = nM * nN; G = G_; c = c_; }
    __host__ __device__ bool next(int i, Unit& u) const {
        const long L = (long)i * G + c; if (L >= nwg) return false;
        int wgid = (int)L; { const int q = nwg / NXCD, r = nwg % NXCD, xcd = wgid % NXCD, off = wgid / NXCD; wgid = (xcd < r ? xcd * (q + 1) : r * (q + 1) + (xcd - r) * q) + off; }
        const int nig = WGM * nN, gid = wgid / nig, fm = gid * WGM, gsz = (nM - fm) < WGM ? (nM - fm) : WGM;
        u.pm = fm + ((wgid % nig) % gsz); u.pn = (wgid % nig) / gsz; return true;
    }
    __device__ __forceinline__ void a_ready(const Unit&) const {}
    __device__ __forceinline__ void done(const Unit&) const {}
};
typedef __bf16 bf16x2_t __attribute__((ext_vector_type(2)));
typedef float f32x2_t __attribute__((ext_vector_type(2)));
__device__ __forceinline__ unsigned cvt_pk_bf16(float lo, float hi) { const f32x2_t v = {lo, hi}; const bf16x2_t r = __builtin_convertvector(v, bf16x2_t); return __builtin_bit_cast(unsigned, r); }
template <class Epi, class Sched, bool ALIGN_EPI = false, bool SP2 = false>
__device__ __forceinline__ void gemm_phase(PG8_LAS unsigned char* lds, const Gemm g, const Sched& S, const Epi& E, const int wid, PG8_LAS float* rsbuf) {
    const int lane = lane_id(), tid = wid * 64 + lane, wr = wid >> 2, wc = wid & 3, fr = lane & 15, fq = lane >> 4;
    const int K = g.K, nt = K / BK;
    unsigned voffA[2], voffB[2];
#pragma unroll
    for (int i = 0; i < 2; ++i) { int R, C; stage_rc(tid * 16 + i * 8192, R, C); const int Rb = Epi::PERM ? ((R & ~31) + perm32(R & 31)) : R;
        voffA[i] = (unsigned)(R * K + C) * 2u; voffB[i] = (unsigned)(Rb * K + C) * 2u; }
    const size_t kstep = (size_t)(BK * 2);
    const size_t hstep = (size_t)HALF * K * 2;
    const size_t tstep = 2 * hstep;
    const unsigned ldsw = (unsigned)wid * 1024u;
    const int aoff = lds_byte(wr * 64 + fr, fq * 8), boff = lds_byte(wc * 32 + fr, fq * 8);
#define PG8_SA(b, h) (((b) * 2 + (h)) * HTB)
#define PG8_SB(b, h) ((4 + (b) * 2 + (h)) * HTB)
#define PG8_STAGE(bufoff, gbase, voff) do { _Pragma("unroll") for (int _i = 0; _i < 2; ++_i) \
        __builtin_amdgcn_global_load_lds((const unsigned*)((const char*)(gbase) + (voff)[_i]), (PG8_LAS unsigned*)(lds + (bufoff) + ldsw + _i * 8192), 16, 0, 0); } while (0)
#define PG8_LDA(dst, b, h) do { _Pragma("unroll") for (int m = 0; m < 4; ++m) _Pragma("unroll") for (int k = 0; k < 2; ++k) dst[m][k] = *(const PG8_LAS bf16x8*)(lds + PG8_SA(b, h) + aoff + m * 2048 + k * 1024); } while (0)
#define PG8_LDB(dst, b, h) do { _Pragma("unroll") for (int n = 0; n < 2; ++n) _Pragma("unroll") for (int k = 0; k < 2; ++k) dst[n][k] = *(const PG8_LAS bf16x8*)(lds + PG8_SB(b, h) + boff + n * 2048 + k * 1024); } while (0)
#define PG8_MMA(ai, bj, At, Bt) do { __builtin_amdgcn_s_setprio(1); _Pragma("unroll") for (int m = 0; m < 4; ++m) _Pragma("unroll") for (int n = 0; n < 2; ++n) _Pragma("unroll") for (int k = 0; k < 2; ++k) \
        acc[ai][bj][m][n] = __builtin_amdgcn_mfma_f32_16x16x32_bf16(Bt[n][k], At[m][k], acc[ai][bj][m][n], 0, 0, 0); __builtin_amdgcn_s_setprio(0); } while (0)
#define PG8_WAIT_V(n) asm volatile("s_waitcnt vmcnt(" #n ")" ::: "memory")
#define PG8_WAIT_L(n) asm volatile("s_waitcnt lgkmcnt(" #n ")" ::: "memory")
#define PG8_BAR __builtin_amdgcn_s_barrier()
#define PG8_SCHED __builtin_amdgcn_sched_barrier(0)
    Unit cur, nxt; int ui = 0;
    if (!S.next(0, cur)) return;
    if constexpr (Epi::USE_RS) E.rs_stage(cur, tid, rsbuf);
    f32x4 acc[2][2][4][2];
#pragma unroll
    for (int a = 0; a < 2; ++a)
#pragma unroll
        for (int b = 0; b < 2; ++b)
#pragma unroll
            for (int m = 0; m < 4; ++m)
#pragma unroll
                for (int n = 0; n < 2; ++n) acc[a][b][m][n] = (f32x4){0.f, 0.f, 0.f, 0.f};
    bf16x8 At[4][2], B0[2][2], B1[2][2];
    const char* cA = (const char*)g.A + (size_t)cur.pm * tstep; const char* cB = (const char*)g.Bt + (size_t)cur.pn * tstep;
    S.a_ready(cur);
    if constexpr (SP2) {
        PG8_STAGE(PG8_SB(0, 0), cB, voffB); PG8_STAGE(PG8_SB(0, 1), cB + hstep, voffB); PG8_STAGE(PG8_SA(0, 0), cA, voffA); PG8_STAGE(PG8_SA(0, 1), cA + hstep, voffA);
        if (wr == 1) PG8_BAR;
        PG8_WAIT_V(2); PG8_BAR;
        PG8_STAGE(PG8_SB(1, 0), cB + kstep, voffB); PG8_STAGE(PG8_SA(1, 0), cA + kstep, voffA); PG8_STAGE(PG8_SB(1, 1), cB + hstep + kstep, voffB);
        PG8_WAIT_V(6); PG8_BAR;
    } else {
        PG8_STAGE(PG8_SB(0, 0), cB, voffB); PG8_STAGE(PG8_SA(0, 0), cA, voffA); PG8_STAGE(PG8_SB(0, 1), cB + hstep, voffB); PG8_STAGE(PG8_SA(0, 1), cA + hstep, voffA);
        if (wr == 1) PG8_BAR;
        PG8_WAIT_V(4); PG8_BAR;
        PG8_STAGE(PG8_SB(1, 0), cB + kstep, voffB); PG8_STAGE(PG8_SA(1, 0), cA + kstep, voffA); PG8_STAGE(PG8_SB(1, 1), cB + hstep + kstep, voffB);
        PG8_WAIT_V(6); PG8_BAR;
    }
    for (;;) {
        const bool has_next = S.next(ui + 1, nxt);
        const char* nA = has_next ? (const char*)g.A + (size_t)nxt.pm * tstep : cA; const char* nB = has_next ? (const char*)g.Bt + (size_t)nxt.pn * tstep : cB;
        for (int t = 0; t < nt; t += 2) {
            const bool last = (t == nt - 2);
            const char* a1 = cA + (size_t)(t + 1) * kstep;
            const char* a2 = last ? nA : cA + (size_t)(t + 2) * kstep; const char* b2 = last ? nB : cB + (size_t)(t + 2) * kstep;
            const char* a3 = a2 + kstep; const char* b3 = b2 + kstep;
            if (last && has_next) S.a_ready(nxt);
            if constexpr (SP2) {
            PG8_LDB(B0, 0, 0); PG8_LDB(B1, 0, 1); PG8_SCHED; PG8_LDA(At, 0, 0); PG8_STAGE(PG8_SA(1, 1), a1 + hstep, voffA);
            PG8_WAIT_V(8); PG8_WAIT_L(0); PG8_BAR; PG8_MMA(0, 0, At, B0); PG8_MMA(0, 1, At, B1); PG8_BAR; PG8_SCHED;
            PG8_LDA(At, 0, 1); PG8_STAGE(PG8_SB(0, 0), b2, voffB); PG8_STAGE(PG8_SB(0, 1), b2 + hstep, voffB); PG8_STAGE(PG8_SA(0, 0), a2, voffA);
            PG8_WAIT_V(8); PG8_WAIT_L(0); PG8_BAR; PG8_MMA(1, 0, At, B0); PG8_MMA(1, 1, At, B1); PG8_BAR; PG8_SCHED;
            PG8_LDB(B0, 1, 0); PG8_LDB(B1, 1, 1); PG8_SCHED; PG8_LDA(At, 1, 0); PG8_STAGE(PG8_SA(0, 1), a2 + hstep, voffA);
            PG8_WAIT_V(8); PG8_WAIT_L(0); PG8_BAR; PG8_MMA(0, 0, At, B0); PG8_MMA(0, 1, At, B1); PG8_BAR; PG8_SCHED;
            PG8_LDA(At, 1, 1); PG8_STAGE(PG8_SB(1, 0), b3, voffB); PG8_STAGE(PG8_SB(1, 1), b3 + hstep, voffB); PG8_STAGE(PG8_SA(1, 0), a3, voffA);
            PG8_WAIT_V(8); PG8_WAIT_L(0); PG8_BAR; PG8_MMA(1, 0, At, B0); PG8_MMA(1, 1, At, B1); PG8_BAR; PG8_SCHED;
            } else {
            PG8_LDB(B0, 0, 0); PG8_SCHED; PG8_LDA(At, 0, 0); PG8_STAGE(PG8_SA(1, 1), a1 + hstep, voffA);
            PG8_WAIT_L(8); PG8_BAR; PG8_WAIT_L(0); PG8_MMA(0, 0, At, B0); PG8_BAR; PG8_SCHED;
            PG8_LDB(B1, 0, 1); PG8_STAGE(PG8_SB(0, 0), b2, voffB);
            PG8_BAR; PG8_WAIT_L(0); PG8_MMA(0, 1, At, B1); PG8_BAR;
            PG8_LDA(At, 0, 1); PG8_STAGE(PG8_SA(0, 0), a2, voffA);
            PG8_BAR; PG8_WAIT_L(0); PG8_MMA(1, 0, At, B0); PG8_BAR; PG8_SCHED;
            PG8_STAGE(PG8_SB(0, 1), b2 + hstep, voffB);
            PG8_WAIT_V(6); PG8_BAR; PG8_MMA(1, 1, At, B1); PG8_BAR;
            PG8_LDB(B0, 1, 0); PG8_SCHED; PG8_LDA(At, 1, 0); PG8_STAGE(PG8_SA(0, 1), a2 + hstep, voffA);
            PG8_WAIT_L(8); PG8_BAR; PG8_WAIT_L(0); PG8_MMA(0, 0, At, B0); PG8_BAR; PG8_SCHED;
            PG8_LDB(B1, 1, 1); PG8_STAGE(PG8_SB(1, 0), b3, voffB);
            PG8_BAR; PG8_WAIT_L(0); PG8_MMA(0, 1, At, B1); PG8_BAR;
            PG8_LDA(At, 1, 1); PG8_STAGE(PG8_SA(1, 0), a3, voffA);
            PG8_BAR; PG8_WAIT_L(0); PG8_MMA(1, 0, At, B0); PG8_BAR; PG8_SCHED;
            PG8_STAGE(PG8_SB(1, 1), b3 + hstep, voffB);
            PG8_WAIT_V(6); PG8_BAR; PG8_MMA(1, 1, At, B1); PG8_BAR;
            }
        }
        if constexpr (ALIGN_EPI) { if (wr == 0) PG8_BAR; }
        if constexpr (!Epi::AFTER_DRAIN) {
            if constexpr (Epi::USE_RS) { if (has_next) E.rs_stage(nxt, tid, rsbuf + 256 * ((ui + 1) & 1)); }
            E(acc, cur, wr, wc, fr, fq, rsbuf + 256 * (ui & 1)); S.done(cur); }
        if (!has_next) break;
#pragma unroll
        for (int a = 0; a < 2; ++a)
#pragma unroll
            for (int b = 0; b < 2; ++b)
#pragma unroll
                for (int m = 0; m < 4; ++m)
#pragma unroll
                    for (int n = 0; n < 2; ++n) acc[a][b][m][n] = (f32x4){0.f, 0.f, 0.f, 0.f};
        cur = nxt; cA = nA; cB = nB; ++ui;
        if constexpr (ALIGN_EPI) { if (wr == 1) PG8_BAR; }
    }
    PG8_WAIT_V(0);
    if constexpr (!ALIGN_EPI) { if (wr == 0) PG8_BAR; }
    PG8_BAR;
    if constexpr (Epi::AFTER_DRAIN) { E.fused(acc, cur, wr, wc, fr, fq, lds, wid, lane); S.done(cur); }
#undef PG8_SA
#undef PG8_SB
#undef PG8_STAGE
#undef PG8_LDA
#undef PG8_LDB
#undef PG8_MMA
#undef PG8_WAIT_V
#undef PG8_WAIT_L
#undef PG8_BAR
#undef PG8_SCHED
}
}
#ifndef PG8_SP2
#define PG8_SP2 true
#endif
#ifndef PG8_ALIGN
#define PG8_ALIGN true
#endif
#define LAS __attribute__((address_space(3)))
typedef unsigned short bf16;
typedef float f32x4 __attribute__((ext_vector_type(4)));
typedef float f32x16 __attribute__((ext_vector_type(16)));
typedef short bf16x8 __attribute__((ext_vector_type(8)));
typedef short s16x4 __attribute__((ext_vector_type(4)));
typedef unsigned u32x4 __attribute__((ext_vector_type(4)));
typedef unsigned u32x2 __attribute__((ext_vector_type(2)));
using pg8::cvt_pk_bf16;
using pg8::Unit;

constexpr int TP = 16384, TS = 1024, T = TP + TS, D = 1024, FF = 2816, NIN = 4096, SEQ = 8192;
constexpr float LOG2E = 1.4426950408889634f;
constexpr float QSCALE = 0.125f * LOG2E;
constexpr float MQSCALE = 0.08838834764831845f * LOG2E;
constexpr float RMS_EPS = 1e-6f;

constexpr size_t MiB = 1u << 20;
constexpr size_t WS_CTL = 0, WS_WGU1 = 1 * MiB, WS_WD1 = 13 * MiB, WS_WIN = 19 * MiB, WS_WAB = 27 * MiB, WS_WOUT = 30 * MiB, WS_WMQ = 32 * MiB,
                 WS_WMKV = 33 * MiB, WS_WMO = 35 * MiB, WS_WGU2 = 36 * MiB, WS_WD2 = 48 * MiB, WS_ROPE = 54 * MiB, WS_SS1 = 55 * MiB, WS_SS2 = 57 * MiB,
                 WS_SS3 = 59 * MiB, WS_SS4 = 61 * MiB, WS_SS5 = 63 * MiB, WS_SSM = 65 * MiB, WS_MEMB = 66 * MiB, WS_MKB = 67 * MiB, WS_MVB = 68 * MiB,
                 WS_XB = 70 * MiB, WS_HB = 104 * MiB, WS_H = 138 * MiB, WS_ACT = 206 * MiB, WS_Z = 300 * MiB, WS_AB = 436 * MiB, WS_MIX = 462 * MiB,
                 WS_QM = 496 * MiB, WS_OM = 513 * MiB, WS_END = 530 * MiB;
constexpr size_t O_Y = 0, O_SWAKP = (size_t)T * D, O_SWAVP = O_SWAKP + 2 * 128 * 2 * 64, O_DILKP = O_SWAVP + 2 * 128 * 2 * 64, O_DILVP = O_DILKP + 2 * 2048 * 4 * 64,
                 O_MEMKP = O_DILVP + 2 * 2048 * 4 * 64, O_MEMVP = O_MEMKP + 2 * 256 * 512, O_SWAKS = O_MEMVP + 2 * 256 * 512, O_SWAVS = O_SWAKS + 1024 * 2 * 64,
                 O_DILKS = O_SWAVS + 1024 * 2 * 64, O_DILVS = O_DILKS + 1024 * 4 * 64, O_END = O_DILVS + 1024 * 4 * 64;
constexpr int LDS_BYTES = 147456;

struct Args { const float* in[30]; float* out; unsigned char* ws; int lo, hi; };

__device__ __forceinline__ float wave_sum(float v) {
#pragma unroll
    for (int o = 1; o < 64; o <<= 1) v += __shfl_xor(v, o);
    return v;
}
__device__ __forceinline__ float fexp2(float x) { return __builtin_amdgcn_exp2f(x); }
__device__ __forceinline__ float frcp(float x) { return __builtin_amdgcn_rcpf(x); }
__device__ __forceinline__ float bf2f(unsigned short b) { return __builtin_bit_cast(float, (unsigned)b << 16); }
__device__ __forceinline__ float row_rs(const float* ss, int row, int nrows = T) {
    const f32x4 a = *(const f32x4*)(ss + ((size_t)0 * nrows + row) * 4), b = *(const f32x4*)(ss + ((size_t)1 * nrows + row) * 4),
                c = *(const f32x4*)(ss + ((size_t)2 * nrows + row) * 4), d = *(const f32x4*)(ss + ((size_t)3 * nrows + row) * 4);
    const float s = (((a.x + a.y) + (a.z + a.w)) + ((b.x + b.y) + (b.z + b.w))) + (((c.x + c.y) + (c.z + c.w)) + ((d.x + d.y) + (d.z + d.w)));
    return rsqrtf(s * (1.0f / 1024.0f) + RMS_EPS);
}
__device__ __forceinline__ u32x4 pack8(const f32x4 a, const f32x4 b) {
    u32x4 w; w.x = cvt_pk_bf16(a.x, a.y); w.y = cvt_pk_bf16(a.z, a.w); w.z = cvt_pk_bf16(b.x, b.y); w.w = cvt_pk_bf16(b.z, b.w); return w;
}

struct EpiGU {
    static constexpr bool PERM = true, AFTER_DRAIN = false, USE_RS = true;
    bf16* act; const float* ss;
    __device__ __forceinline__ void rs_stage(const Unit& u, int tid, LAS float* buf) const { if (tid < 256) buf[tid] = row_rs(ss, u.pm * 256 + tid) * 1.0f; }
    __device__ __forceinline__ void operator()(const f32x4 (&acc)[2][2][4][2], const Unit& u, int wr, int wc, int fr, int fq, const LAS float* rsl) const {
        const int row0 = u.pm * 256 + wr * 64 + fr, col0 = u.pn * 128 + wc * 32 + 8 * fq;
#pragma unroll
        for (int ai = 0; ai < 2; ++ai)
#pragma unroll
            for (int m = 0; m < 4; ++m) {
                const int row = row0 + ai * 128 + m * 16; const float rs = rsl[ai * 128 + wr * 64 + m * 16 + fr];
                f32x4 o[2];
#pragma unroll
                for (int n = 0; n < 2; ++n)
#pragma unroll
                    for (int e = 0; e < 4; ++e) { const float g = acc[ai][0][m][n][e] * rs, up = acc[ai][1][m][n][e] * rs;
                        o[n][e] = g * frcp(1.0f + fexp2(-g * LOG2E)) * up; }
                *(u32x4*)(act + (size_t)row * FF + col0) = pack8(o[0], o[1]);
            }
    }
};
struct EpiRES {
    static constexpr bool PERM = true, AFTER_DRAIN = false, USE_RS = false;
    const float* res0; const float* res1; float* out; bf16* hb; float* ss; float alpha;
    __device__ __forceinline__ const float* rptr(int row, int col0) const { return (row < TP ? res0 + (size_t)row * D : res1 + (size_t)(row - TP) * D) + col0; }
    __device__ __forceinline__ void operator()(const f32x4 (&acc)[2][2][4][2], const Unit& u, int wr, int wc, int fr, int fq, const LAS float* rsl) const {
        const int row0 = u.pm * 256 + wr * 64 + fr, col0 = u.pn * 256 + wc * 32 + 8 * fq;
        f32x4 rn[4];
        { const float* rp = rptr(row0, col0); rn[0] = *(const f32x4*)rp; rn[1] = *(const f32x4*)(rp + 4); rn[2] = *(const f32x4*)(rp + 128); rn[3] = *(const f32x4*)(rp + 132); }
#pragma unroll
        for (int ai = 0; ai < 2; ++ai)
#pragma unroll
            for (int m = 0; m < 4; ++m) {
                const int row = row0 + ai * 128 + m * 16;
                f32x4 rc[4];
#pragma unroll
                for (int i = 0; i < 4; ++i) rc[i] = rn[i];
                if (ai * 4 + m < 7) { const int nr = row0 + ((ai * 4 + m + 1) >> 2) * 128 + ((ai * 4 + m + 1) & 3) * 16; const float* rp = rptr(nr, col0);
                    rn[0] = *(const f32x4*)rp; rn[1] = *(const f32x4*)(rp + 4); rn[2] = *(const f32x4*)(rp + 128); rn[3] = *(const f32x4*)(rp + 132); }
                float s = 0.f;
#pragma unroll
                for (int bj = 0; bj < 2; ++bj) {
                    const f32x4 v0 = rc[2 * bj] + acc[ai][bj][m][0] * alpha, v1 = rc[2 * bj + 1] + acc[ai][bj][m][1] * alpha;
                    float* op = out + (size_t)row * D + col0 + bj * 128;
                    *(f32x4*)op = v0; *(f32x4*)(op + 4) = v1;
                    if (hb) *(u32x4*)(hb + (size_t)row * D + col0 + bj * 128) = pack8(v0, v1);
                    s += (v0.x * v0.x + v0.y * v0.y) + (v0.z * v0.z + v0.w * v0.w) + (v1.x * v1.x + v1.y * v1.y) + (v1.z * v1.z + v1.w * v1.w);
                }
                s += __shfl_xor(s, 16); s += __shfl_xor(s, 32);
                if (fq == 0) __hip_atomic_store(ss + ((size_t)u.pn * T + row) * 4 + wc, s, __ATOMIC_RELAXED, __HIP_MEMORY_SCOPE_AGENT);
            }
    }
};
struct EpiMEMKV {
    static constexpr bool PERM = true, AFTER_DRAIN = false, USE_RS = true;
    float* ok; float* ov; bf16* kb; bf16* vb; const float* ss;
    __device__ __forceinline__ void rs_stage(const Unit& u, int tid, LAS float* buf) const { if (tid < 256) buf[tid] = row_rs(ss, u.pm * 256 + tid, 512) * 1.0f; }
    __device__ __forceinline__ void operator()(const f32x4 (&acc)[2][2][4][2], const Unit& u, int wr, int wc, int fr, int fq, const LAS float* rsl) const {
        const int row0 = u.pm * 256 + wr * 64 + fr, col0 = (u.pn & 1) * 256 + wc * 32 + 8 * fq;
        float* of = (u.pn < 2) ? ok : ov; bf16* ob = (u.pn < 2) ? kb : vb;
#pragma unroll
        for (int ai = 0; ai < 2; ++ai)
#pragma unroll
            for (int m = 0; m < 4; ++m) {
                const int row = row0 + ai * 128 + m * 16; const float rs = rsl[ai * 128 + wr * 64 + m * 16 + fr];
#pragma unroll
                for (int bj = 0; bj < 2; ++bj) {
                    const f32x4 v0 = acc[ai][bj][m][0] * rs, v1 = acc[ai][bj][m][1] * rs;
                    float* op = of + (size_t)row * 512 + col0 + bj * 128;
                    *(f32x4*)op = v0; *(f32x4*)(op + 4) = v1;
                    *(u32x4*)(ob + (size_t)row * 512 + col0 + bj * 128) = pack8(v0, v1);
                }
            }
    }
};
struct EpiQM {
    static constexpr bool PERM = true, AFTER_DRAIN = false, USE_RS = true;
    bf16* qm; const float* ss;
    __device__ __forceinline__ void rs_stage(const Unit& u, int tid, LAS float* buf) const { if (tid < 256) buf[tid] = row_rs(ss, u.pm * 256 + tid) * MQSCALE; }
    __device__ __forceinline__ void operator()(const f32x4 (&acc)[2][2][4][2], const Unit& u, int wr, int wc, int fr, int fq, const LAS float* rsl) const {
        const int row0 = u.pm * 256 + wr * 64 + fr, col0 = u.pn * 256 + wc * 32 + 8 * fq;
#pragma unroll
        for (int ai = 0; ai < 2; ++ai)
#pragma unroll
            for (int m = 0; m < 4; ++m) {
                const int row = row0 + ai * 128 + m * 16; const float rs = rsl[ai * 128 + wr * 64 + m * 16 + fr];
#pragma unroll
                for (int bj = 0; bj < 2; ++bj)
                    *(u32x4*)(qm + (size_t)row * 512 + col0 + bj * 128) = pack8(acc[ai][bj][m][0] * rs, acc[ai][bj][m][1] * rs);
            }
    }
};
struct EpiBRANCH {
    static constexpr bool PERM = true, AFTER_DRAIN = false, USE_RS = false;
    bf16* mixed; const bf16* Z;
    __device__ __forceinline__ void operator()(const f32x4 (&acc)[2][2][4][2], const Unit& u, int wr, int wc, int fr, int fq, const LAS float* rsl) const {
        const int row0 = u.pm * 256 + wr * 64 + fr, j0 = u.pn * 128 + wc * 32 + 8 * fq;
        bf16x8 gan = *(const bf16x8*)(Z + (size_t)row0 * NIN + 2048 + j0), gbn = *(const bf16x8*)(Z + (size_t)row0 * NIN + 3072 + j0);
#pragma unroll
        for (int ai = 0; ai < 2; ++ai)
#pragma unroll
            for (int m = 0; m < 4; ++m) {
                const int row = row0 + ai * 128 + m * 16;
                const bf16x8 ga = gan, gb = gbn;
                if (ai * 4 + m < 7) { const int nr = row0 + ((ai * 4 + m + 1) >> 2) * 128 + ((ai * 4 + m + 1) & 3) * 16;
                    gan = *(const bf16x8*)(Z + (size_t)nr * NIN + 2048 + j0); gbn = *(const bf16x8*)(Z + (size_t)nr * NIN + 3072 + j0); }
                f32x4 o[2];
#pragma unroll
                for (int n = 0; n < 2; ++n)
#pragma unroll
                    for (int e = 0; e < 4; ++e)
                        o[n][e] = bf2f((unsigned short)ga[4 * n + e]) * acc[ai][0][m][n][e] + bf2f((unsigned short)gb[4 * n + e]) * acc[ai][1][m][n][e];
                *(u32x4*)(mixed + (size_t)row * D + j0) = pack8(o[0], o[1]);
            }
    }
};
struct EpiZIN {
    static constexpr bool PERM = true, AFTER_DRAIN = false, USE_RS = true;
    bf16* Z; const float* ss; const float* rope; float* out;
    __device__ __forceinline__ void rs_stage(const Unit& u, int tid, LAS float* buf) const { if (tid < 256) buf[tid] = row_rs(ss, u.pm * 256 + tid) * 1.0f; }
    __device__ __forceinline__ void operator()(const f32x4 (&acc)[2][2][4][2], const Unit& u, int wr, int wc, int fr, int fq, const LAS float* rsl) const {
        const int row0 = u.pm * 256 + wr * 64 + fr;
#pragma unroll
        for (int bj = 0; bj < 2; ++bj) {
            const int cbase = u.pn * 256 + bj * 128 + wc * 32;
            const int c0 = cbase + 8 * fq;
            if (cbase >= 2048) {
#pragma unroll
                for (int ai = 0; ai < 2; ++ai)
#pragma unroll
                    for (int m = 0; m < 4; ++m) {
                        const int row = row0 + ai * 128 + m * 16; const float rs = rsl[ai * 128 + wr * 64 + m * 16 + fr];
                        f32x4 o[2];
#pragma unroll
                        for (int n = 0; n < 2; ++n)
#pragma unroll
                            for (int e = 0; e < 4; ++e) o[n][e] = frcp(1.0f + fexp2(-acc[ai][bj][m][n][e] * rs * LOG2E));
                        *(u32x4*)(Z + (size_t)row * NIN + c0) = pack8(o[0], o[1]);
                    }
            } else {
                const int slot = cbase >> 6, dimbase = cbase & 63;
                const bool is_v = (slot == 10) || (slot == 11) || (slot >= 28);
                const bool is_q = (slot < 8) || (slot >= 12 && slot < 24);
                const bool is_kv = !is_q;
                const bool do_rope = (!is_v) && (dimbase == 0);
                const float qs = is_q ? QSCALE : 1.0f;
                int nkv = 2, keep = 128, kvh = 0; size_t op_p = 0, op_s = 0;
                if (slot == 8 || slot == 9) { kvh = slot - 8; op_p = O_SWAKP; op_s = O_SWAKS; }
                else if (slot == 10 || slot == 11) { kvh = slot - 10; op_p = O_SWAVP; op_s = O_SWAVS; }
                else if (slot >= 24 && slot < 28) { kvh = slot - 24; nkv = 4; keep = 2048; op_p = O_DILKP; op_s = O_DILKS; }
                else if (slot >= 28) { kvh = slot - 28; nkv = 4; keep = 2048; op_p = O_DILVP; op_s = O_DILVS; }
#pragma unroll
                for (int ai = 0; ai < 2; ++ai)
#pragma unroll
                    for (int m = 0; m < 4; ++m) {
                        const int row = row0 + ai * 128 + m * 16; const float rs = rsl[ai * 128 + wr * 64 + m * 16 + fr];
                        f32x4 v[2]; v[0] = acc[ai][bj][m][0] * rs; v[1] = acc[ai][bj][m][1] * rs;
                        if (do_rope) {
                            f32x4 ot[2];
#pragma unroll
                            for (int n = 0; n < 2; ++n)
#pragma unroll
                                for (int e = 0; e < 4; ++e) ot[n][e] = __shfl_xor(v[n][e], 16);
                            if (fq < 2) {
                                const int pi = (row < TP) ? (row & (SEQ - 1)) : (SEQ + ((row - TP) & 7));
                                const f32x4* cs = (const f32x4*)(rope + (size_t)pi * 16);
                                const float sg = (fq == 0) ? -1.0f : 1.0f;
#pragma unroll
                                for (int n = 0; n < 2; ++n) {
                                    const f32x4 c01 = cs[2 * n], c23 = cs[2 * n + 1];
                                    v[n][0] = v[n][0] * c01.x + sg * ot[n][0] * c01.y;
                                    v[n][1] = v[n][1] * c01.z + sg * ot[n][1] * c01.w;
                                    v[n][2] = v[n][2] * c23.x + sg * ot[n][2] * c23.y;
                                    v[n][3] = v[n][3] * c23.z + sg * ot[n][3] * c23.w;
                                }
                            }
                        }
                        if (is_kv) {
                            float* op = nullptr;
                            if (row < TP) { const int b = row >> 13, s = row & (SEQ - 1);
                                if (s >= SEQ - keep) op = out + op_p + ((size_t)(b * keep + s - (SEQ - keep)) * nkv + kvh) * 64 + dimbase + 8 * fq; }
                            else op = out + op_s + ((size_t)(row - TP) * nkv + kvh) * 64 + dimbase + 8 * fq;
                            if (op) { *(f32x4*)op = v[0]; *(f32x4*)(op + 4) = v[1]; }
                        }
                        *(u32x4*)(Z + (size_t)row * NIN + c0) = pack8(v[0] * qs, v[1] * qs);
                    }
            }
        }
    }
};

template <bool F32> __device__ __forceinline__ bf16x8 ld8(const void* p, int eoff) {
    if constexpr (F32) { const f32x4* f = (const f32x4*)((const float*)p + eoff); const f32x4 a = f[0], b = f[1]; return __builtin_bit_cast(bf16x8, pack8(a, b)); }
    else return *(const bf16x8*)((const bf16*)p + eoff);
}
typedef short v4i16_t __attribute__((ext_vector_type(4)));
__device__ __forceinline__ s16x4 vtr(const LAS unsigned char* p) { return __builtin_bit_cast(s16x4, __builtin_amdgcn_ds_read_tr16_b64_v4i16((LAS v4i16_t*)p)); }
#define MFMA32(a, b, c) __builtin_amdgcn_mfma_f32_32x32x16_bf16((a), (b), (c), 0, 0, 0)

template <int DH, bool F32> struct RawKV;
template <int DH> struct RawKV<DH, false> {
    bf16x8 k[DH / 16], v[DH / 16];
    __device__ __forceinline__ void load(const void* krow, const void* vrow, int lane) {
        const int h = lane >> 5;
#pragma unroll
        for (int i = 0; i < DH / 16; ++i) { k[i] = *(const bf16x8*)((const bf16*)krow + 16 * i + 8 * h); v[i] = *(const bf16x8*)((const bf16*)vrow + (lane & 1) * (DH / 2) + 8 * i); }
    }
    __device__ __forceinline__ bf16x8 kf(int i) const { return k[i]; }
    __device__ __forceinline__ bf16x8 vf(int i) const { return v[i]; }
};
template <int DH> struct RawKV<DH, true> {
    f32x4 k[DH / 8], v[DH / 8];
    __device__ __forceinline__ void load(const void* krow, const void* vrow, int lane) {
        const int h = lane >> 5;
#pragma unroll
        for (int i = 0; i < DH / 16; ++i) {
            const f32x4* kp = (const f32x4*)((const float*)krow + 16 * i + 8 * h); k[2 * i] = kp[0]; k[2 * i + 1] = kp[1];
            const f32x4* vp = (const f32x4*)((const float*)vrow + (lane & 1) * (DH / 2) + 8 * i); v[2 * i] = vp[0]; v[2 * i + 1] = vp[1];
        }
    }
    __device__ __forceinline__ bf16x8 kf(int i) const { return __builtin_bit_cast(bf16x8, pack8(k[2 * i], k[2 * i + 1])); }
    __device__ __forceinline__ bf16x8 vf(int i) const { return __builtin_bit_cast(bf16x8, pack8(v[2 * i], v[2 * i + 1])); }
};
template <int DH> __device__ __forceinline__ void pack_kv(RawKV<DH, false>& d, const RawKV<DH, true>& s) {
#pragma unroll
    for (int i = 0; i < DH / 16; ++i) { d.k[i] = s.kf(i); d.v[i] = s.vf(i); }
}
template <int DH> struct Flash {
    static constexpr int VS = DH * 2 + 16;
    float m, l; f32x16 O[DH / 32];
    __device__ __forceinline__ void init() {
        m = -INFINITY; l = 0.f;
#pragma unroll
        for (int d = 0; d < DH / 32; ++d)
#pragma unroll
            for (int r = 0; r < 16; ++r) O[d][r] = 0.f;
    }
    __device__ __forceinline__ void loadq(bf16x8 (&qb)[DH / 16], const bf16* qrow, int h) const {
#pragma unroll
        for (int ks = 0; ks < DH / 16; ++ks) qb[ks] = ld8<false>(qrow, 16 * ks + 8 * h);
    }
    template <bool F32> __device__ __forceinline__ void step(const void* krow, const void* vrow, const bf16x8 (&qb)[DH / 16], unsigned vmask, LAS unsigned char* vl, int lane) {
        {   LAS unsigned char* dst = vl + (lane >> 1) * VS + (lane & 1) * DH;
#pragma unroll
            for (int k = 0; k < DH / 16; ++k) *(LAS bf16x8*)(dst + 16 * k) = ld8<F32>(vrow, (lane & 1) * (DH / 2) + 8 * k);
        }
        const int h = lane >> 5;
        f32x16 s;
#pragma unroll
        for (int r = 0; r < 16; ++r) s[r] = 0.f;
#pragma unroll
        for (int ks = 0; ks < DH / 16; ++ks) { const bf16x8 ka = ld8<F32>(krow, 16 * ks + 8 * h); s = MFMA32(ka, qb[ks], s); }
        float mx = -INFINITY;
#pragma unroll
        for (int r = 0; r < 16; ++r) { const float v = ((vmask >> r) & 1u) ? s[r] : -INFINITY; s[r] = v; mx = fmaxf(mx, v); }
        mx = fmaxf(mx, __shfl_xor(mx, 32));
        const float mn = fmaxf(m, mx), mu = (mn == -INFINITY) ? 0.f : mn;
        const float alpha = fexp2(m - mu);
        float ls = 0.f;
#pragma unroll
        for (int r = 0; r < 16; ++r) { const float p = fexp2(s[r] - mu); s[r] = p; ls += p; }
        l = l * alpha + ls;
        if (__any(mn != m)) {
#pragma unroll
            for (int d = 0; d < DH / 32; ++d)
#pragma unroll
                for (int r = 0; r < 16; ++r) O[d][r] *= alpha;
        }
        m = mn;
        bf16x8 pb[2];
#pragma unroll
        for (int s2 = 0; s2 < 2; ++s2) {
            u32x4 w; w.x = cvt_pk_bf16(s[8 * s2 + 0], s[8 * s2 + 1]); w.y = cvt_pk_bf16(s[8 * s2 + 2], s[8 * s2 + 3]);
            w.z = cvt_pk_bf16(s[8 * s2 + 4], s[8 * s2 + 5]); w.w = cvt_pk_bf16(s[8 * s2 + 6], s[8 * s2 + 7]);
            pb[s2] = __builtin_bit_cast(bf16x8, w);
        }
        asm volatile("" ::: "memory");
        const int i16 = lane & 15, q = i16 >> 2, p4 = i16 & 3, blk = (lane >> 4) & 1;
        const LAS unsigned char* vb = vl + (4 * h + q) * VS + (16 * blk + 4 * p4) * 2;
#pragma unroll
        for (int d = 0; d < DH / 32; ++d)
#pragma unroll
            for (int s2 = 0; s2 < 2; ++s2) {
                const s16x4 lo = vtr(vb + (16 * s2) * VS + d * 64), hi = vtr(vb + (16 * s2 + 8) * VS + d * 64);
                const bf16x8 va = __builtin_shufflevector(lo, hi, 0, 1, 2, 3, 4, 5, 6, 7);
                O[d] = MFMA32(va, pb[s2], O[d]);
            }
        asm volatile("" ::: "memory");
    }
    template <bool F32> __device__ __forceinline__ void step_raw(const RawKV<DH, F32>& kv, const bf16x8 (&qb)[DH / 16], unsigned vmask, LAS unsigned char* vl, int lane) {
        {   LAS unsigned char* dst = vl + (lane >> 1) * VS + (lane & 1) * DH;
#pragma unroll
            for (int k = 0; k < DH / 16; ++k) *(LAS bf16x8*)(dst + 16 * k) = kv.vf(k);
        }
        const int h = lane >> 5;
        f32x16 s;
#pragma unroll
        for (int r = 0; r < 16; ++r) s[r] = 0.f;
#pragma unroll
        for (int ks = 0; ks < DH / 16; ++ks) s = MFMA32(kv.kf(ks), qb[ks], s);
        float mx = -INFINITY;
#pragma unroll
        for (int r = 0; r < 16; ++r) { const float v = ((vmask >> r) & 1u) ? s[r] : -INFINITY; s[r] = v; mx = fmaxf(mx, v); }
        mx = fmaxf(mx, __shfl_xor(mx, 32));
        const float mn = fmaxf(m, mx), mu = (mn == -INFINITY) ? 0.f : mn;
        const float alpha = fexp2(m - mu);
        float ls = 0.f;
#pragma unroll
        for (int r = 0; r < 16; ++r) { const float p = fexp2(s[r] - mu); s[r] = p; ls += p; }
        l = l * alpha + ls;
        if (__any(mn != m)) {
#pragma unroll
            for (int d = 0; d < DH / 32; ++d)
#pragma unroll
                for (int r = 0; r < 16; ++r) O[d][r] *= alpha;
        }
        m = mn;
        bf16x8 pb[2];
#pragma unroll
        for (int s2 = 0; s2 < 2; ++s2) {
            u32x4 w; w.x = cvt_pk_bf16(s[8 * s2 + 0], s[8 * s2 + 1]); w.y = cvt_pk_bf16(s[8 * s2 + 2], s[8 * s2 + 3]);
            w.z = cvt_pk_bf16(s[8 * s2 + 4], s[8 * s2 + 5]); w.w = cvt_pk_bf16(s[8 * s2 + 6], s[8 * s2 + 7]);
            pb[s2] = __builtin_bit_cast(bf16x8, w);
        }
        asm volatile("" ::: "memory");
        const int i16 = lane & 15, q = i16 >> 2, p4 = i16 & 3, blk = (lane >> 4) & 1;
        const LAS unsigned char* vb = vl + (4 * h + q) * VS + (16 * blk + 4 * p4) * 2;
#pragma unroll
        for (int d = 0; d < DH / 32; ++d)
#pragma unroll
            for (int s2 = 0; s2 < 2; ++s2) {
                const s16x4 lo = vtr(vb + (16 * s2) * VS + d * 64), hi = vtr(vb + (16 * s2 + 8) * VS + d * 64);
                const bf16x8 va = __builtin_shufflevector(lo, hi, 0, 1, 2, 3, 4, 5, 6, 7);
                O[d] = MFMA32(va, pb[s2], O[d]);
            }
        asm volatile("" ::: "memory");
    }
    __device__ __forceinline__ float ltot() const { return l + __shfl_xor(l, 32); }
    __device__ __forceinline__ void write(bf16* dst, float inv, int h) const {
#pragma unroll
        for (int d = 0; d < DH / 32; ++d)
#pragma unroll
            for (int g = 0; g < 4; ++g) {
                u32x2 w; w.x = cvt_pk_bf16(O[d][4 * g] * inv, O[d][4 * g + 1] * inv); w.y = cvt_pk_bf16(O[d][4 * g + 2] * inv, O[d][4 * g + 3] * inv);
                *(u32x2*)(dst + 32 * d + 8 * g + 4 * h) = w;
            }
    }
};
__device__ __forceinline__ unsigned rows_to_vmask(unsigned rowmask, int h) { const unsigned x = rowmask >> (4 * h); return (x & 0xFu) | ((x >> 4) & 0xF0u) | ((x >> 8) & 0xF00u) | ((x >> 12) & 0xF000u); }
__device__ __forceinline__ unsigned range_mask(int lo, int hi) { lo = max(lo, 0); hi = min(hi, 31); return (lo <= hi) ? ((0xFFFFFFFFu >> (31 - hi)) & (0xFFFFFFFFu << lo)) : 0u; }
__device__ __forceinline__ int crow16(int r, int h) { return (r & 3) + 8 * (r >> 2) + 4 * h; }

__device__ __forceinline__ void task_pB(int tix, const bf16* Z, bf16* AB, LAS unsigned char* vl, int lane) {
    const int b = tix >> 10, kv = (tix >> 8) & 3, r = (tix >> 4) & 15, ub = tix & 15;
    const int c = lane & 31, h = lane >> 5;
    const int pq0 = r + 16 * (32 * ub), pq = pq0 + 16 * c;
    const bf16* Zb = Z + (size_t)(b * SEQ) * NIN;
    Flash<64> F; F.init();
    for (int g = 2; g >= 0; --g) {
        const int sh = 2 * g, nch = (g == 2) ? 5 : ((g == 1) ? 8 : 20);
        bf16x8 qb[4]; F.loadq(qb, Zb + (size_t)pq * NIN + 768 + (g * 4 + kv) * 64, h);
        const int kstart = pq0 - (128 << sh);
        int ch0 = 0;
        while (kstart + ((32 * ch0 + 31) << sh) < 0) ++ch0;
        const bf16* kbase = Zb + 1536 + kv * 64; const bf16* vbase = Zb + 1792 + kv * 64;
        RawKV<64, false> cur, nxt;
        { const int base = kstart + ((32 * ch0) << sh);
          cur.load(kbase + (size_t)min(max(base + (c << sh), 0), SEQ - 1) * NIN, vbase + (size_t)min(max(base + ((lane >> 1) << sh), 0), SEQ - 1) * NIN, lane); }
        for (int ch = ch0; ch < nch; ++ch) {
            const int base = kstart + ((32 * ch) << sh);
            { const int bn = kstart + ((32 * min(ch + 1, nch - 1)) << sh);
              nxt.load(kbase + (size_t)min(max(bn + (c << sh), 0), SEQ - 1) * NIN, vbase + (size_t)min(max(bn + ((lane >> 1) << sh), 0), SEQ - 1) * NIN, lane); }
            const int e_ = (pq - base) >> sh, i0_ = (base < 0) ? ((-base + (1 << sh) - 1) >> sh) : 0;
            const unsigned vmask = rows_to_vmask(range_mask(max(e_ - 128, i0_), e_), h);
            F.step_raw<false>(cur, qb, vmask, vl, lane);
            cur = nxt;
        }
    }
    const float inv = 1.0f / F.ltot();
    F.write(AB + (size_t)(b * SEQ + pq) * 768 + 512 + kv * 64, inv, h);
}
__device__ __forceinline__ void task_pA(int tix, const bf16* Z, bf16* AB, const float* sink, LAS unsigned char* vl, int lane) {
    const int b = tix >> 11, hd = (tix >> 8) & 7, tb = tix & 255, kv = hd >> 2;
    const int c = lane & 31, h = lane >> 5, pq = 32 * tb + c;
    const bf16* Zb = Z + (size_t)(b * SEQ) * NIN;
    Flash<64> F; F.init();
    bf16x8 qb[4]; F.loadq(qb, Zb + (size_t)pq * NIN + hd * 64, h);
    const int ch0 = (tb < 4) ? (4 - tb) : 0;
    const bf16* kbase = Zb + 512 + kv * 64; const bf16* vbase = Zb + 640 + kv * 64;
    RawKV<64, false> cur, nxt;
    { const int base = 32 * tb - 128 + 32 * ch0; cur.load(kbase + (size_t)max(base + c, 0) * NIN, vbase + (size_t)max(base + (lane >> 1), 0) * NIN, lane); }
    for (int ch = ch0; ch < 5; ++ch) {
        const int base = 32 * tb - 128 + 32 * ch;
        { const int bn = 32 * tb - 128 + 32 * min(ch + 1, 4); nxt.load(kbase + (size_t)max(bn + c, 0) * NIN, vbase + (size_t)max(bn + (lane >> 1), 0) * NIN, lane); }
        const unsigned vmask = rows_to_vmask(range_mask(max(pq - base - 128, -base), pq - base), h);
        F.step_raw<false>(cur, qb, vmask, vl, lane);
        cur = nxt;
    }
    const float inv = 1.0f / (F.ltot() + fexp2(sink[hd] * LOG2E - F.m));
    F.write(AB + (size_t)(b * SEQ + pq) * 768 + hd * 64, inv, h);
}
__device__ __forceinline__ const float* sA_row(const float* cache, const float* fresh, int b, int kv, int k) {
    const int kk = min(k, 135);
    return (kk < 128) ? cache + ((size_t)(b * 128 + kk) * 2 + kv) * 64 : fresh + ((size_t)(b * 8 + kk - 128) * 2 + kv) * 64;
}
__device__ __forceinline__ void task_sA(int tix, const bf16* Z, bf16* AB, const float* sink, const float* ck, const float* cv, const float* nk, const float* nv,
                                        LAS unsigned char* vl, int lane) {
    const int b = tix >> 1, kv = tix & 1;
    const int c = lane & 31, h = lane >> 5, t = c & 7, hd = kv * 4 + (c >> 3);
    const int row = TP + b * 8 + t;
    Flash<64> F; F.init();
    bf16x8 qb[4]; F.loadq(qb, Z + (size_t)row * NIN + hd * 64, h);
    RawKV<64, false> cur; RawKV<64, true> nxt;
    nxt.load(sA_row(ck, nk, b, kv, c), sA_row(cv, nv, b, kv, lane >> 1), lane); pack_kv<64>(cur, nxt);
    for (int ch = 0; ch < 5; ++ch) {
        { const int cn = min(ch + 1, 4); nxt.load(sA_row(ck, nk, b, kv, 32 * cn + c), sA_row(cv, nv, b, kv, 32 * cn + (lane >> 1)), lane); }
        const unsigned vmask = rows_to_vmask(range_mask(t - 32 * ch, 128 + t - 32 * ch), h);
        F.step_raw<false>(cur, qb, vmask, vl, lane);
        pack_kv<64>(cur, nxt);
    }
    const float inv = 1.0f / (F.ltot() + fexp2(sink[hd] * LOG2E - F.m));
    F.write(AB + (size_t)row * 768 + hd * 64, inv, h);
}
__device__ __forceinline__ int sB_kidx(int ch, int i) { return (ch < 24) ? 16 * (4 * ch + (i >> 3)) + (i & 7) : 1536 + 32 * (ch - 24) + i; }
__device__ __forceinline__ const float* sB_row(const float* cache, const float* fresh, int b, int kv, int k) {
    const int kk = min(k, 2055);
    return (kk < 2048) ? cache + ((size_t)(b * 2048 + kk) * 4 + kv) * 64 : fresh + ((size_t)(b * 8 + kk - 2048) * 4 + kv) * 64;
}
__device__ __forceinline__ void task_sB(int tix, const bf16* Z, bf16* AB, const float* ck, const float* cv, const float* nk, const float* nv, LAS unsigned char* vl, int lane) {
    const int b = tix >> 2, kv = tix & 3;
    const int c = lane & 31, h = lane >> 5, t = c & 7, g = c >> 3, ge = min(g, 2), sh = 2 * ge;
    const int row = TP + b * 8 + t;
    Flash<64> F; F.init();
    bf16x8 qb[4]; F.loadq(qb, Z + (size_t)row * NIN + 768 + (ge * 4 + kv) * 64, h);
    RawKV<64, false> cur; RawKV<64, true> nxt;
    nxt.load(sB_row(ck, nk, b, kv, sB_kidx(0, c)), sB_row(cv, nv, b, kv, sB_kidx(0, lane >> 1)), lane); pack_kv<64>(cur, nxt);
    for (int ch = 0; ch < 41; ++ch) {
        { const int cn = min(ch + 1, 40); nxt.load(sB_row(ck, nk, b, kv, sB_kidx(cn, c)), sB_row(cv, nv, b, kv, sB_kidx(cn, lane >> 1)), lane); }
        unsigned vmask;
        if (ch < 24) vmask = (g == 2 && h == (t >> 2)) ? (0x1111u << (t & 3)) : 0u;
        else { const int E = 512 + t - 32 * (ch - 24);
            const unsigned per = (sh == 0) ? 0xFFFFFFFFu : ((sh == 2) ? (0x11111111u << (t & 3)) : (0x00010001u << t));
            vmask = (g < 3) ? rows_to_vmask(range_mask(E - (128 << sh), E) & per, h) : 0u; }
        F.step_raw<false>(cur, qb, vmask, vl, lane);
        pack_kv<64>(cur, nxt);
    }
    const float lt = F.ltot();
    const int src = (lane & 32) + t;
    const float m0 = __shfl(F.m, src), m1 = __shfl(F.m, src + 8), m2 = __shfl(F.m, src + 16);
    const float l0 = __shfl(lt, src), l1 = __shfl(lt, src + 8), l2 = __shfl(lt, src + 16);
    const float M = fmaxf(m0, fmaxf(m1, m2));
    const float w0 = fexp2(m0 - M), w1 = fexp2(m1 - M), w2 = fexp2(m2 - M);
    const float inv = 1.0f / (w0 * l0 + w1 * l1 + w2 * l2);
#pragma unroll
    for (int d = 0; d < 2; ++d)
#pragma unroll
        for (int r = 0; r < 16; ++r) { const float o = F.O[d][r]; F.O[d][r] = w0 * __shfl(o, src) + w1 * __shfl(o, src + 8) + w2 * __shfl(o, src + 16); }
    if (g == 0) F.write(AB + (size_t)row * 768 + 512 + kv * 64, inv, h);
}
__device__ __forceinline__ void task_xP(int tix, const bf16* qm, const bf16* mkb, const bf16* mvb, bf16* om, LAS unsigned char* vl, int lane) {
    const int b = tix >> 10, hd = (tix >> 8) & 3, tile = tix & 255;
    const int c = lane & 31, h = lane >> 5, row = b * SEQ + 32 * tile + c;
    Flash<128> F; F.init();
    bf16x8 qb[8]; F.loadq(qb, qm + (size_t)row * 512 + hd * 128, h);
    for (int ch = 0; ch < 8; ++ch)
        F.step<false>(mkb + (size_t)(b * 256 + 32 * ch + c) * 512 + hd * 128, mvb + (size_t)(b * 256 + 32 * ch + (lane >> 1)) * 512 + hd * 128, qb, 0xffffu, vl, lane);
    const float inv = 1.0f / F.ltot();
    F.write(om + (size_t)row * 512 + hd * 128, inv, h);
}
__device__ __forceinline__ void task_xS(int tix, const bf16* qm, const float* ck, const float* cv, bf16* om, LAS unsigned char* vl, int lane) {
    const int b = tix >> 2, hd = tix & 3;
    const int c = lane & 31, h = lane >> 5, row = TP + b * 8 + (c & 7);
    Flash<128> F; F.init();
    bf16x8 qb[8]; F.loadq(qb, qm + (size_t)row * 512 + hd * 128, h);
    for (int ch = 0; ch < 8; ++ch)
        F.step<true>(ck + ((size_t)(b * 256 + 32 * ch + c) * 4 + hd) * 128, cv + ((size_t)(b * 256 + 32 * ch + (lane >> 1)) * 4 + hd) * 128, qb, 0xffffu, vl, lane);
    const float inv = 1.0f / F.ltot();
    if (c < 8) F.write(om + (size_t)row * 512 + hd * 128, inv, h);
}
__device__ __forceinline__ int next_task(unsigned* ctr, int lane) {
    int t = 0;
    if (lane == 0) t = (int)__hip_atomic_fetch_add(ctr, 1u, __ATOMIC_RELAXED, __HIP_MEMORY_SCOPE_AGENT);
    return __builtin_amdgcn_readfirstlane(t);
}

__device__ __forceinline__ void mini_gemm_res(const bf16* A, const bf16* Bt, int K, const float* res, float* out, bf16* hb, float* ss, float alpha, int unit, int wave, int lane,
                                              LAS float* red) {
    const int c = lane & 31, h = lane >> 5;
    const int row0 = TP + 32 * (unit >> 4) + c, cs = unit & 15, c0 = 64 * cs, kw = K >> 3;
    const bf16* ap0 = A + (size_t)row0 * K + wave * kw + 8 * h;
    const bf16* ap1 = ap0 + (size_t)512 * K;
    const bf16* b0 = Bt + (size_t)(c0 + c) * K + wave * kw + 8 * h;
    const bf16* b1 = b0 + (size_t)32 * K;
    f32x16 acc[2][2];
#pragma unroll
    for (int i = 0; i < 2; ++i)
#pragma unroll
        for (int j = 0; j < 2; ++j)
#pragma unroll
            for (int r = 0; r < 16; ++r) acc[i][j][r] = 0.f;
#pragma unroll 4
    for (int ks = 0; ks < kw; ks += 16) {
        const bf16x8 a0 = *(const bf16x8*)(ap0 + ks), a1 = *(const bf16x8*)(ap1 + ks), w0 = *(const bf16x8*)(b0 + ks), w1 = *(const bf16x8*)(b1 + ks);
        acc[0][0] = MFMA32(w0, a0, acc[0][0]); acc[0][1] = MFMA32(w1, a0, acc[0][1]);
        acc[1][0] = MFMA32(w0, a1, acc[1][0]); acc[1][1] = MFMA32(w1, a1, acc[1][1]);
    }
#pragma unroll
    for (int i = 0; i < 2; ++i)
#pragma unroll
        for (int j = 0; j < 2; ++j)
#pragma unroll
            for (int g = 0; g < 4; ++g)
                *(LAS f32x4*)(red + i * 16384 + ((wave * 8 + 4 * j + g) * 64 + lane) * 4) = (f32x4){acc[i][j][4 * g], acc[i][j][4 * g + 1], acc[i][j][4 * g + 2], acc[i][j][4 * g + 3]};
    __syncthreads();
    const int cb = wave >> 2, g = wave & 3;
#pragma unroll
    for (int i = 0; i < 2; ++i) {
        f32x4 sum = (f32x4){0.f, 0.f, 0.f, 0.f};
#pragma unroll
        for (int k = 0; k < 8; ++k) sum += *(const LAS f32x4*)(red + i * 16384 + ((k * 8 + wave) * 64 + lane) * 4);
        const size_t off = (size_t)(row0 + 512 * i) * D + c0 + 32 * cb + 8 * g + 4 * h;
        const f32x4 v = *(const f32x4*)(res + off) + sum * alpha;
        *(f32x4*)(out + off) = v;
        if (hb) { u32x2 w; w.x = cvt_pk_bf16(v.x, v.y); w.y = cvt_pk_bf16(v.z, v.w); *(u32x2*)(hb + off) = w; }
        red[32768 + i * 512 + wave * 64 + lane] = (v.x * v.x + v.y * v.y) + (v.z * v.z + v.w * v.w);
    }
    __syncthreads();
    if (wave < 2) {
        float t = 0.f;
#pragma unroll
        for (int k = 0; k < 8; ++k) t += red[32768 + wave * 512 + k * 64 + lane];
        t += __shfl_xor(t, 32);
        if (h == 0) __hip_atomic_store(ss + ((size_t)(cs >> 2) * T + row0 + 512 * wave) * 4 + (cs & 3), t, __ATOMIC_RELAXED, __HIP_MEMORY_SCOPE_AGENT);
    }
    __syncthreads();
}

__device__ __forceinline__ void tr_item(const float* W, int N, const float* gain, bf16* WT, int ldk, int koff, int blk, int blk_stride, int blk_off,
                                        LAS float* scr, int item, int lane) {
    const int nblk = N >> 5, kb = item / nblk, nb = item - kb * nblk, k0 = kb * 64, n0 = nb * 32;
    const int kr = lane >> 3, n4 = (lane & 7) * 4;
    f32x4 v[8]; float gs[8];
#pragma unroll
    for (int i = 0; i < 8; ++i) { v[i] = __builtin_nontemporal_load((const f32x4*)(W + (size_t)(k0 + 8 * i + kr) * N + n0 + n4)); gs[i] = gain ? gain[k0 + 8 * i + kr] : 1.0f; }
#pragma unroll
    for (int i = 0; i < 8; ++i) { LAS float* d = scr + (8 * i + kr) * 33 + n4; const f32x4 x = v[i] * gs[i]; d[0] = x.x; d[1] = x.y; d[2] = x.z; d[3] = x.w; }
    asm volatile("s_waitcnt lgkmcnt(0)" ::: "memory");
    const int c = lane & 7;
#pragma unroll
    for (int j = 0; j < 4; ++j) { const int n = (lane >> 3) + 8 * j; const LAS float* s = scr + (8 * c) * 33 + n;
        u32x4 o; o.x = cvt_pk_bf16(s[0 * 33], s[1 * 33]); o.y = cvt_pk_bf16(s[2 * 33], s[3 * 33]); o.z = cvt_pk_bf16(s[4 * 33], s[5 * 33]); o.w = cvt_pk_bf16(s[6 * 33], s[7 * 33]);
        const int nn = n0 + n, drow = (nn / blk) * blk_stride + blk_off + (nn % blk);
        *(u32x4*)(WT + (size_t)drow * ldk + koff + k0 + 8 * c) = o; }
    asm volatile("s_waitcnt lgkmcnt(0)" ::: "memory");
}
__device__ __forceinline__ void row_to_bf16(const float* xrow, bf16* orow, float* ss, int row, int nrows, int lane) {
    const f32x4* xr = (const f32x4*)xrow + lane;
    f32x4 v[4]; float s = 0.f;
#pragma unroll
    for (int j = 0; j < 4; ++j) { v[j] = __builtin_nontemporal_load(xr + 64 * j); s += (v[j].x * v[j].x + v[j].y * v[j].y) + (v[j].z * v[j].z + v[j].w * v[j].w); }
    s = wave_sum(s);
    u32x2* o8 = (u32x2*)orow + lane;
#pragma unroll
    for (int j = 0; j < 4; ++j) { u32x2 w; w.x = cvt_pk_bf16(v[j].x, v[j].y); w.y = cvt_pk_bf16(v[j].z, v[j].w); o8[64 * j] = w; }
    if (lane < 16) __hip_atomic_store(ss + ((size_t)(lane >> 2) * nrows + row) * 4 + (lane & 3), (lane == 0) ? s : 0.f, __ATOMIC_RELAXED, __HIP_MEMORY_SCOPE_AGENT);
}
__device__ __forceinline__ void sincos_d(double r, float& c, float& s) {
    const double r2 = r * r;
    double sc = 1.0, ss = 1.0;
    double tc = 1.0, ts = 1.0;
#pragma unroll
    for (int k = 1; k <= 14; ++k) { tc *= -r2 / (double)((2 * k - 1) * (2 * k)); ts *= -r2 / (double)((2 * k) * (2 * k + 1)); sc += tc; ss += ts; }
    c = (float)sc; s = (float)(ss * r);
}

#define XB_TMO      128
#define XB_XCNT(j)  (256  + 64 * (j))
#define XB_XSUB(j)  (1280 + 64 * (j))
#define XB_XGEN(j)  (2304 + 64 * (j))
#define XB_TOP      3328
#define XB_TOPGEN   3392
#define XCD_BAR_WORDS 3456
#define XB_SPIN_CAP (1u << 18)

__device__ __forceinline__ unsigned xb_ld(unsigned* p)              { return __hip_atomic_load(p, __ATOMIC_RELAXED, __HIP_MEMORY_SCOPE_AGENT); }
__device__ __forceinline__ unsigned xb_add(unsigned* p, unsigned v) { return __hip_atomic_fetch_add(p, v, __ATOMIC_RELAXED, __HIP_MEMORY_SCOPE_AGENT); }
__device__ __forceinline__ unsigned xb_xcc_id() { return (unsigned)__builtin_amdgcn_s_getreg((3 << 11) | 20) & 0xFu; }
#define XB_SPIN(cond, bar) do { unsigned _sp = 0; while (cond) { __builtin_amdgcn_s_sleep(1); \
    if ((++_sp & 255u) == 0u) { if (xb_ld(&(bar)[XB_TMO])) break; if (_sp > XB_SPIN_CAP) { atomicAdd(&(bar)[XB_TMO], 1u); break; } } } } while (0)

struct XcdBarrier {
    unsigned* bar; unsigned x;
    volatile LAS unsigned* st;
};

__device__ __forceinline__ XcdBarrier xcd_barrier_post(unsigned* bar, volatile LAS unsigned* st, bool t0) {
    XcdBarrier b; b.bar = bar; b.x = xb_xcc_id(); b.st = st;
    if (t0) (void)xb_add(&bar[XB_XCNT(b.x)], 1u);
    return b;
}
__device__ __forceinline__ void xcd_barrier_complete(unsigned* bar, unsigned x, unsigned& nloc, unsigned& nx) {
    const unsigned G = gridDim.x * gridDim.y * gridDim.z;
    unsigned sum, cnt, mine, sp = 0u;
    for (;;) {
        sum = 0u; cnt = 0u; mine = 0u;
#pragma unroll
        for (unsigned j = 0; j < 16; ++j) { const unsigned c = xb_ld(&bar[XB_XCNT(j)]); sum += c; cnt += (c > 0u) ? 1u : 0u; mine = (j == x) ? c : mine; }
        if (sum == G) break;
        __builtin_amdgcn_s_sleep(1);
        if ((++sp & 255u) == 0u) { if (xb_ld(&bar[XB_TMO])) break; if (sp > XB_SPIN_CAP) { atomicAdd(&bar[XB_TMO], 1u); break; } }
    }
    nloc = mine > 0u ? mine : 1u; nx = cnt > 0u ? cnt : 1u;
}

__device__ __forceinline__ void xcd_barrier(const XcdBarrier& b, bool t0) {
    asm volatile("s_waitcnt vmcnt(0)" ::: "memory");
    __syncthreads();
    if (t0) {
        unsigned* bar = b.bar;
        __builtin_amdgcn_s_waitcnt(0);
        unsigned nloc = b.st[0], nx = b.st[1];
        if (nloc == 0u) { xcd_barrier_complete(bar, b.x, nloc, nx); b.st[0] = nloc; b.st[1] = nx; }
        const unsigned old = xb_add(&bar[XB_XSUB(b.x)], 1u);
        const unsigned gen = old / nloc;
        if (old + 1u == (gen + 1u) * nloc) {
            __builtin_amdgcn_fence(__ATOMIC_RELEASE, "agent");
            asm volatile("s_waitcnt vmcnt(0)" ::: "memory");
            const unsigned og = xb_add(&bar[XB_TOP], 1u);
            const unsigned tg = og / nx;
            if (og + 1u == (tg + 1u) * nx) xb_add(&bar[XB_TOPGEN], 1u);
            else XB_SPIN(xb_ld(&bar[XB_TOPGEN]) == tg, bar);
            __builtin_amdgcn_fence(__ATOMIC_ACQUIRE, "agent");
            xb_add(&bar[XB_XGEN(b.x)], 1u);
            asm volatile("s_waitcnt vmcnt(0)" ::: "memory");
        } else {
            XB_SPIN(xb_ld(&bar[XB_XGEN(b.x)]) == gen, bar);
            __builtin_amdgcn_fence(__ATOMIC_ACQUIRE, "agent");
            asm volatile("s_waitcnt vmcnt(0)" ::: "memory");
        }
    }
    __syncthreads();
}

#ifndef REP_P0
#define REP_P0 1
#endif
#ifndef REP_GEMM
#define REP_GEMM 1
#endif
#ifndef REP_SYNC
#define REP_SYNC 1
#endif
#define CG_SYNC() do { asm volatile("s_waitcnt vmcnt(0)" ::: "memory"); grid.sync(); \
    if (wave == 0) { __builtin_amdgcn_fence(__ATOMIC_ACQUIRE, "agent"); asm volatile("s_waitcnt vmcnt(0)" ::: "memory"); } __syncthreads(); } while (0)
#define GRID_SYNC() for (int rs_ = 0; rs_ < REP_SYNC; ++rs_) do { XcdBarrier xb_; xb_.bar = (unsigned*)(a.ws + WS_CTL) + 1024; xb_.x = xb_xcc_id(); xb_.st = (volatile LAS unsigned*)(lds + 147200); \
    xcd_barrier(xb_, wave == 0 && lane_id() == 0); } while (0)
#define WSP(type, off) ((type*)(ws + (off)))
#define ctl WSP(unsigned, WS_CTL)
#define WGU1 WSP(bf16, WS_WGU1)
#define WD1 WSP(bf16, WS_WD1)
#define WIN WSP(bf16, WS_WIN)
#define WAB WSP(bf16, WS_WAB)
#define WOUT WSP(bf16, WS_WOUT)
#define WMQ WSP(bf16, WS_WMQ)
#define WMKV WSP(bf16, WS_WMKV)
#define WMO WSP(bf16, WS_WMO)
#define WGU2 WSP(bf16, WS_WGU2)
#define WD2 WSP(bf16, WS_WD2)
#define ROPE WSP(float, WS_ROPE)
#define SS1 WSP(float, WS_SS1)
#define SS2 WSP(float, WS_SS2)
#define SS3 WSP(float, WS_SS3)
#define SS4 WSP(float, WS_SS4)
#define SS5 WSP(float, WS_SS5)
#define SSM WSP(float, WS_SSM)
#define MEMB WSP(bf16, WS_MEMB)
#define MKB WSP(bf16, WS_MKB)
#define MVB WSP(bf16, WS_MVB)
#define XB WSP(bf16, WS_XB)
#define HB WSP(bf16, WS_HB)
#define H WSP(float, WS_H)
#define ACT WSP(bf16, WS_ACT)
#define Z WSP(bf16, WS_Z)
#define AB WSP(bf16, WS_AB)
#define MIX WSP(bf16, WS_MIX)
#define QM WSP(bf16, WS_QM)
#define OM WSP(bf16, WS_OM)
#define PHASE_PTRS unsigned char* ws; float* out; { unsigned long long w_ = (unsigned long long)a.ws, o_ = (unsigned long long)a.out; asm volatile("" : "+s"(w_), "+s"(o_)); ws = (unsigned char*)(__attribute__((address_space(1))) unsigned char*)w_; out = (float*)(__attribute__((address_space(1))) float*)o_; }
#define IN(k) (a.lo <= (k) && (k) < a.hi)
__global__ void __launch_bounds__(512, 2) fwd(Args a) {
    extern __shared__ __attribute__((aligned(16))) unsigned char lds_raw[];
    LAS unsigned char* lds = (LAS unsigned char*)lds_raw;
    cg::grid_group grid = cg::this_grid();
    const int wave = __builtin_amdgcn_readfirstlane(threadIdx.x >> 6);
    const int G = gridDim.x, bid = blockIdx.x;
    {
        const bool t0 = (wave == 0 && lane_id() == 0);
        if (t0) { ((volatile LAS unsigned*)(lds + 147200))[0] = 0u; ((volatile LAS unsigned*)(lds + 147200))[1] = 0u; }
        __syncthreads();
        (void)xcd_barrier_post((unsigned*)(a.ws + WS_CTL) + 1024, (volatile LAS unsigned*)(lds + 147200), t0);
    }
    const int gw = bid * 8 + wave, NGW = G * 8;

    if (IN(0)) for (int rp_ = 0; rp_ < REP_P0; ++rp_) {
        PHASE_PTRS
        const int lane = lane_id(), tid = wave * 64 + lane;
        LAS float* scr = (LAS float*)(lds + wave * 16384);
        constexpr int NI = 12416;
        for (int it = gw; it < NI; it += NGW) {
            int r = it;
            if (r < 1408) { tr_item(a.in[10], FF, a.in[9], WGU1, D, 0, 128, 256, 0, scr, r, lane); continue; } r -= 1408;
            if (r < 1408) { tr_item(a.in[11], FF, a.in[9], WGU1, D, 0, 128, 256, 128, scr, r, lane); continue; } r -= 1408;
            if (r < 1408) { tr_item(a.in[12], D, nullptr, WD1, FF, 0, D, 0, 0, scr, r, lane); continue; } r -= 1408;
            if (r < 2048) { tr_item(a.in[14], NIN, a.in[13], WIN, D, 0, NIN, 0, 0, scr, r, lane); continue; } r -= 2048;
            if (r < 256) { tr_item(a.in[16], D, nullptr, WAB, 768, 0, 128, 256, 0, scr, r, lane); continue; } r -= 256;
            if (r < 128) { tr_item(a.in[17], D, nullptr, WAB, 768, 512, 128, 256, 128, scr, r, lane); continue; } r -= 128;
            if (r < 512) { tr_item(a.in[18], D, nullptr, WOUT, D, 0, D, 0, 0, scr, r, lane); continue; } r -= 512;
            if (r < 256) { tr_item(a.in[21], 512, a.in[19], WMQ, D, 0, 512, 0, 0, scr, r, lane); continue; } r -= 256;
            if (r < 256) { tr_item(a.in[22], 512, a.in[20], WMKV, D, 0, 512, 0, 0, scr, r, lane); continue; } r -= 256;
            if (r < 256) { tr_item(a.in[23], 512, a.in[20], WMKV, D, 0, 512, 0, 512, scr, r, lane); continue; } r -= 256;
            if (r < 256) { tr_item(a.in[24], D, nullptr, WMO, 512, 0, D, 0, 0, scr, r, lane); continue; } r -= 256;
            if (r < 1408) { tr_item(a.in[26], FF, a.in[25], WGU2, D, 0, 128, 256, 0, scr, r, lane); continue; } r -= 1408;
            if (r < 1408) { tr_item(a.in[27], FF, a.in[25], WGU2, D, 0, 128, 256, 128, scr, r, lane); continue; } r -= 1408;
            tr_item(a.in[28], D, nullptr, WD2, FF, 0, D, 0, 0, scr, r, lane);
        }
        for (int idx = bid * 512 + tid; idx < 2048 * 96; idx += G * 512) {
            const int row = idx / 96, k = (idx - row * 96) * 8; const bool isA = (row & 255) < 128;
            if (isA ? (k >= 512) : (k < 512)) *(u32x4*)(WAB + (size_t)row * 768 + k) = (u32x4){0u, 0u, 0u, 0u};
        }
        for (int m = gw; m < T; m += NGW) row_to_bf16(m < TP ? a.in[0] + (size_t)m * D : a.in[1] + (size_t)(m - TP) * D, XB + (size_t)m * D, SS1, m, T, lane);
        for (int m = gw; m < 512; m += NGW) row_to_bf16(a.in[8] + (size_t)m * D, MEMB + (size_t)m * D, SSM, m, 512, lane);
        for (int idx = bid * 512 + tid; idx < 8200 * 8; idx += G * 512) {
            const int pi = idx >> 3, i = idx & 7; const int pos = (pi < SEQ) ? pi : pi + SEQ;
            const float invf[8] = {1.0f, 0.1939227432012558f, 0.03760603070259094f, 0.007292664609849453f, 0.0014142135623842478f, 0.00027424818836152554f, 5.318296098266728e-05f, 1.0313386155758053e-05f};
            float fr_ = 1.0f;
#pragma unroll
            for (int q = 0; q < 8; ++q) if (i == q) fr_ = invf[q];
            const float ang = (float)pos * fr_;
            const double ad = (double)ang, qd = __builtin_rint(ad * 0.15915494309189535), rd = ad - qd * 6.283185307179586;
            float cc, sn; sincos_d(rd, cc, sn);
            ROPE[(size_t)idx * 2] = cc; ROPE[(size_t)idx * 2 + 1] = sn;
        }
    }
    if (IN(0) && IN(1)) GRID_SYNC();
    if (a.lo > 64) CG_SYNC();
    if (IN(1)) {
        PHASE_PTRS
        pg8::Gemm g{XB, WGU1, T, 2 * FF, D}; pg8::StaticOrder S; S.init(T, 2 * FF, G, bid);
        EpiGU E{ACT, SS1};
        for (int rg_ = 0; rg_ < REP_GEMM; ++rg_) pg8::gemm_phase<EpiGU, pg8::StaticOrder, PG8_ALIGN, PG8_SP2>(lds, g, S, E, wave, (LAS float*)(lds + 131072));
        pg8::Gemm g2{MEMB, WMKV, 512, 1024, D}; pg8::StaticOrder S2; S2.init(512, 1024, G, G - 1 - bid);
        EpiMEMKV E2{out + O_MEMKP, out + O_MEMVP, MKB, MVB, SSM};
        for (int rg_ = 0; rg_ < REP_GEMM; ++rg_) pg8::gemm_phase<EpiMEMKV, pg8::StaticOrder, PG8_ALIGN, PG8_SP2>(lds, g2, S2, E2, wave, (LAS float*)(lds + 131072));
    }
    if (IN(1) && IN(2)) GRID_SYNC();
    if (IN(2)) {
        PHASE_PTRS
        pg8::Gemm g{ACT, WD1, TP, D, FF}; pg8::StaticOrder S; S.init(TP, D, G, bid);
        EpiRES E{a.in[0], a.in[1], H, HB, SS2, 0.5f};
        for (int rg_ = 0; rg_ < REP_GEMM; ++rg_) pg8::gemm_phase<EpiRES, pg8::StaticOrder, PG8_ALIGN, PG8_SP2>(lds, g, S, E, wave, (LAS float*)(lds + 131072));
        for (int u_ = bid; u_ < 256; u_ += G) mini_gemm_res(ACT, WD1, 2816, a.in[1] - (size_t)TP * D, H, HB, SS2, 0.5f, u_, wave, lane_id(), (LAS float*)lds);
    }
    if (IN(2) && IN(3)) GRID_SYNC();
    if (IN(3)) {
        PHASE_PTRS
        pg8::Gemm g{HB, WIN, T, NIN, D}; pg8::StaticOrder S; S.init(T, NIN, G, bid);
        EpiZIN E{Z, SS2, ROPE, out};
        for (int rg_ = 0; rg_ < REP_GEMM; ++rg_) pg8::gemm_phase<EpiZIN, pg8::StaticOrder, PG8_ALIGN, PG8_SP2>(lds, g, S, E, wave, (LAS float*)(lds + 131072));
    }
    if (IN(3) && IN(4)) GRID_SYNC();
    if (IN(4)) {
        PHASE_PTRS
        const int lane = lane_id();
        LAS unsigned char* vl = lds + wave * 8704;
#ifndef REP_ATTN
#define REP_ATTN 1
#endif
        const int x0 = (int)(xb_xcc_id() & 7u);
        for (int k = 0; k < 8; ++k) {
            const int x = (x0 + k) & 7;
            for (;;) {
                const int j = next_task(ctl + 64 * x, lane);
                if (j >= 864) break;
                if (j < 64) task_sB(64 * x + j, Z, AB, a.in[4], a.in[5], out + O_DILKS, out + O_DILVS, vl, lane);
                else if (j < 320) task_pB((x << 8) | (j - 64), Z, AB, vl, lane);
                else if (j < 352) task_sA(32 * x + (j - 320), Z, AB, a.in[15], a.in[2], a.in[3], out + O_SWAKS, out + O_SWAVS, vl, lane);
                else { const int jj = j - 352, hd = ((x >> 1) & 1) * 4 + (x & 1) * 2 + (jj >> 8);
                    task_pA(((x >> 2) << 11) | (hd << 8) | (jj & 255), Z, AB, a.in[15], vl, lane); }
            }
        }
    }
    if (IN(4) && IN(5)) GRID_SYNC();
    if (IN(5)) {
        PHASE_PTRS
        pg8::Gemm g{AB, WAB, T, 2048, 768}; pg8::StaticOrder S; S.init(T, 2048, G, bid);
        EpiBRANCH E{MIX, Z};
        for (int rg_ = 0; rg_ < REP_GEMM; ++rg_) pg8::gemm_phase<EpiBRANCH, pg8::StaticOrder, PG8_ALIGN, PG8_SP2>(lds, g, S, E, wave, (LAS float*)(lds + 131072));
    }
    if (IN(5) && IN(6)) GRID_SYNC();
    if (IN(6)) {
        PHASE_PTRS
        pg8::Gemm g{MIX, WOUT, TP, D, D}; pg8::StaticOrder S; S.init(TP, D, G, bid);
        EpiRES E{H, H + (size_t)TP * D, H, HB, SS3, 1.0f};
        pg8::gemm_phase<EpiRES, pg8::StaticOrder, PG8_ALIGN, PG8_SP2>(lds, g, S, E, wave, (LAS float*)(lds + 131072));
        for (int u_ = bid; u_ < 256; u_ += G) mini_gemm_res(MIX, WOUT, 1024, H, H, HB, SS3, 1.0f, u_, wave, lane_id(), (LAS float*)lds);
    }
    if (IN(6) && IN(7)) GRID_SYNC();
    if (IN(7)) {
        PHASE_PTRS
        pg8::Gemm g{HB, WMQ, T, 512, D}; pg8::StaticOrder S; S.init(T, 512, G, bid);
        EpiQM E{QM, SS3};
        for (int rg_ = 0; rg_ < REP_GEMM; ++rg_) pg8::gemm_phase<EpiQM, pg8::StaticOrder, PG8_ALIGN, PG8_SP2>(lds, g, S, E, wave, (LAS float*)(lds + 131072));
    }
    if (IN(7) && IN(8)) GRID_SYNC();
    if (IN(8)) {
        PHASE_PTRS
        const int lane = lane_id();
        LAS unsigned char* vl = lds + wave * 8704;
        const int x0 = (int)(xb_xcc_id() & 7u);
        for (int k = 0; k < 8; ++k) {
            const int x = (x0 + k) & 7;
            for (;;) {
                const int j = next_task(ctl + 512 + 64 * x, lane);
                if (j >= 320) break;
                if (j < 64) task_xS(64 * x + j, QM, a.in[6], a.in[7], OM, vl, lane);
                else task_xP((x << 8) | (j - 64), QM, MKB, MVB, OM, vl, lane);
            }
        }
    }
    if (IN(8) && IN(9)) GRID_SYNC();
    if (IN(9)) {
        PHASE_PTRS
        pg8::Gemm g{OM, WMO, TP, D, 512}; pg8::StaticOrder S; S.init(TP, D, G, bid);
        EpiRES E{H, H + (size_t)TP * D, H, HB, SS4, 1.0f};
        pg8::gemm_phase<EpiRES, pg8::StaticOrder, PG8_ALIGN, PG8_SP2>(lds, g, S, E, wave, (LAS float*)(lds + 131072));
        for (int u_ = bid; u_ < 256; u_ += G) mini_gemm_res(OM, WMO, 512, H, H, HB, SS4, 1.0f, u_, wave, lane_id(), (LAS float*)lds);
    }
    if (IN(9) && IN(10)) GRID_SYNC();
    if (IN(10)) {
        PHASE_PTRS
        pg8::Gemm g{HB, WGU2, T, 2 * FF, D}; pg8::StaticOrder S; S.init(T, 2 * FF, G, bid);
        EpiGU E{ACT, SS4};
        for (int rg_ = 0; rg_ < REP_GEMM; ++rg_) pg8::gemm_phase<EpiGU, pg8::StaticOrder, PG8_ALIGN, PG8_SP2>(lds, g, S, E, wave, (LAS float*)(lds + 131072));
    }
    if (IN(10) && IN(11)) GRID_SYNC();
    if (IN(11)) {
        PHASE_PTRS
        pg8::Gemm g{ACT, WD2, TP, D, FF}; pg8::StaticOrder S; S.init(TP, D, G, bid);
        EpiRES E{H, H + (size_t)TP * D, H, nullptr, SS5, 0.5f};
        pg8::gemm_phase<EpiRES, pg8::StaticOrder, PG8_ALIGN, PG8_SP2>(lds, g, S, E, wave, (LAS float*)(lds + 131072));
        for (int u_ = bid; u_ < 256; u_ += G) mini_gemm_res(ACT, WD2, 2816, H, H, (bf16*)nullptr, SS5, 0.5f, u_, wave, lane_id(), (LAS float*)lds);
    }
    if (IN(11) && IN(12)) GRID_SYNC();
    if (IN(12)) for (int rp_ = 0; rp_ < REP_P0; ++rp_) {
        PHASE_PTRS
        const int lane = lane_id();
        const f32x4* gn = (const f32x4*)a.in[29] + lane;
        f32x4 gv[4];
#pragma unroll
        for (int j = 0; j < 4; ++j) gv[j] = gn[64 * j];
        for (int m = gw; m < T; m += NGW) {
            const f32x4* hr = (const f32x4*)(H + (size_t)m * D) + lane;
            f32x4 v[4]; float s = 0.f;
#pragma unroll
            for (int j = 0; j < 4; ++j) { v[j] = hr[64 * j]; s += (v[j].x * v[j].x + v[j].y * v[j].y) + (v[j].z * v[j].z + v[j].w * v[j].w); }
            const float rs = rsqrtf(wave_sum(s) * (1.0f / 1024.0f) + RMS_EPS);
            f32x4* yr = (f32x4*)(out + O_Y + (size_t)m * D) + lane;
#pragma unroll
            for (int j = 0; j < 4; ++j) __builtin_nontemporal_store(v[j] * rs * gv[j], yr + 64 * j);
        }
    }
}

extern "C" void kernel_launch(void* const* d_in, const int* in_sizes, int n_in, void* d_out, int out_size, void* d_ws, size_t ws_size, hipStream_t stream) {
    static int grid = 0;
    if (grid == 0) {
        if (n_in != 30 || (size_t)out_size != O_END || ws_size < WS_END) { fprintf(stderr, "kernel_launch: unexpected problem shape (n_in %d, out %d, ws %zu)\n", n_in, out_size, ws_size); grid = -1; return; }
        int dev = 0, cus = 0, per_cu = 0;
        hipGetDevice(&dev);
        hipDeviceGetAttribute(&cus, hipDeviceAttributeMultiprocessorCount, dev);
        hipFuncSetAttribute((const void*)fwd, hipFuncAttributeMaxDynamicSharedMemorySize, LDS_BYTES);
        hipOccupancyMaxActiveBlocksPerMultiprocessor(&per_cu, (const void*)fwd, 512, LDS_BYTES);
        if (per_cu < 1) { fprintf(stderr, "kernel_launch: occupancy query says %d blocks per CU\n", per_cu); per_cu = 1; }
        (void)hipGetLastError();
        grid = cus * per_cu;
    }
    if (grid < 0) return;
    hipMemsetAsync((char*)d_ws + WS_CTL, 0, 32768, stream);
    Args a{};
    for (int i = 0; i < 30; ++i) a.in[i] = (const float*)d_in[i];
    a.out = (float*)d_out; a.ws = (unsigned char*)d_ws;
#ifndef NLAUNCH
#define NLAUNCH 1
#endif
    for (int li = 0; li < NLAUNCH; ++li) {
        a.lo = (NLAUNCH == 1) ? 0 : li; a.hi = (NLAUNCH == 1) ? 13 : li + 1;
        void* args[] = {&a};
        hipError_t e = hipLaunchCooperativeKernel((const void*)fwd, dim3(grid), dim3(512), args, LDS_BYTES, stream);
        if (e != hipSuccess) { fprintf(stderr, "cooperative launch failed: %s (grid %d)\n", hipGetErrorString(e), grid); break; }
    }
}
```
